# Optimizing an MI355X kernel written in HIP

```python
import math
import jax
import jax.numpy as jnp
from jax import lax
import numpy as np

D_MODEL = 2048
BATCH = 4
SEQ = 4096
DEPTH = 2

GRID_W = 64
CTX_LEN = 256
HEAD_DIM = 128
A_HEADS = D_MODEL // (2 * HEAD_DIM)
A_KV_HEADS = A_HEADS // 4
B_HEADS = D_MODEL // (4 * HEAD_DIM)
C_HEADS = D_MODEL // (4 * HEAD_DIM)
A_Q = A_HEADS * HEAD_DIM
A_KV = A_KV_HEADS * HEAD_DIM
B_W = B_HEADS * HEAD_DIM
C_W = C_HEADS * HEAD_DIM
MIX_W = A_Q + B_W + C_W
Q_BLOCK = 128
ROPE_THETA = 10000.0
NA_WIN_H = 8
NA_WIN_W = 16
CONV_K = 3
DN_CHUNK = 64
EPS = 1e-6
ALPHA = (2 * DEPTH) ** 0.25
OUT_INIT = (8 * DEPTH) ** -0.25
IN_SPLITS = (A_Q, A_KV, A_KV, A_Q, B_W, B_W, B_W, B_W, 3 * C_W, C_W, 4 * C_HEADS)
IN_W = sum(IN_SPLITS)

kernel_name = 'hybrid_grid_flow_block'


def _layernorm(x, g=None, b=None):
    xf = x.astype(jnp.float32)
    xc = xf - jnp.mean(xf, -1, keepdims=True)
    y = xc * lax.rsqrt(jnp.mean(xc * xc, -1, keepdims=True) + EPS)
    if g is not None:
        y = y * g.astype(jnp.float32) + b.astype(jnp.float32)
    return y.astype(x.dtype)


def _rmsnorm(x, g):
    xf = x.astype(jnp.float32)
    y = xf * lax.rsqrt(jnp.mean(xf * xf, -1, keepdims=True) + EPS) * g.astype(jnp.float32)
    return y.astype(x.dtype)


def _l2norm(x):
    return x * lax.rsqrt(jnp.sum(x * x, -1, keepdims=True) + EPS)


def _heads(t, n):
    return t.reshape(t.shape[:-1] + (n, HEAD_DIM))


def _split_in(p):
    return jnp.split(p, np.cumsum(IN_SPLITS)[:-1].tolist(), axis=-1)


def _axial_rope_tables(n_tokens):
    t = jnp.arange(n_tokens, dtype=jnp.int32)
    row = (t // GRID_W).astype(jnp.float32)
    col = (t % GRID_W).astype(jnp.float32)
    half = HEAD_DIM // 2
    inv_freq = ROPE_THETA ** (-jnp.arange(0, half, 2, dtype=jnp.float32) / half)
    ang = jnp.concatenate([row[:, None] * inv_freq, col[:, None] * inv_freq], -1)
    return jnp.cos(ang), jnp.sin(ang)


def _apply_axial_rope(x, cos, sin):
    B, T, H, D = x.shape
    xf = x.astype(jnp.float32).reshape(B, T, H, 2, 2, D // 4)
    x1, x2 = xf[..., 0, :], xf[..., 1, :]
    c = cos.reshape(T, 1, 2, D // 4)
    s = sin.reshape(T, 1, 2, D // 4)
    out = jnp.stack([x1 * c - x2 * s, x2 * c + x1 * s], axis=-2)
    return out.reshape(B, T, H, D).astype(x.dtype)


def _dense_attention(q, k, v):
    B, T, Hq, D = q.shape
    Hkv = k.shape[2]
    qg = q.reshape(B, T, Hkv, Hq // Hkv, D)
    s = jnp.einsum('bqkgd,bskd->bkgqs', qg, k, preferred_element_type=jnp.float32) * D ** -0.5
    p = jax.nn.softmax(s, axis=-1).astype(v.dtype)
    return jnp.einsum('bkgqs,bskd->bqkgd', p, v).reshape(B, T, Hq * D)


def _grid_attention(q, k, v, k_ctx, v_ctx):
    B, S, _, D = q.shape
    G = A_HEADS // A_KV_HEADS
    k_all = jnp.concatenate([k_ctx, k], axis=1)
    v_all = jnp.concatenate([v_ctx, v], axis=1)
    nblk = S // Q_BLOCK
    qb = q.reshape(B, nblk, Q_BLOCK, A_KV_HEADS, G, D).transpose(1, 0, 2, 3, 4, 5)
    scale = D ** -0.5

    def block(qi):
        s = jnp.einsum('bqkgd,bskd->bkgqs', qi, k_all, preferred_element_type=jnp.float32) * scale
        p = jax.nn.softmax(s, axis=-1).astype(v_all.dtype)
        return jnp.einsum('bkgqs,bskd->bqkgd', p, v_all)

    o = lax.map(block, qb)
    return o.transpose(1, 0, 2, 3, 4, 5).reshape(B, S, A_HEADS * D)


def _neighbourhood_attention(q, k, v, k_ctx, v_ctx, rpb, rows):
    B, S, H, D = q.shape
    wh = min(NA_WIN_H, rows)
    qg = q.reshape(B, rows, GRID_W, H, D).transpose(1, 0, 2, 3, 4)
    kg = k.reshape(B, rows, GRID_W, H, D)
    vg = v.reshape(B, rows, GRID_W, H, D)
    r = jnp.arange(rows, dtype=jnp.int32)
    r0 = jnp.clip(r - wh // 2, 0, rows - wh)
    cq = jnp.arange(GRID_W, dtype=jnp.int32)
    c0 = jnp.clip(cq - NA_WIN_W // 2, 0, GRID_W - NA_WIN_W)
    col_idx = c0[:, None] + jnp.arange(NA_WIN_W, dtype=jnp.int32)
    bias_c = col_idx - cq[:, None] + (NA_WIN_W - 1)
    nw = wh * NA_WIN_W
    scale = D ** -0.5

    def row_block(args):
        q_row, r_q, r_start = args
        k_win = lax.dynamic_slice_in_dim(kg, r_start, wh, axis=1)[:, :, col_idx]
        v_win = lax.dynamic_slice_in_dim(vg, r_start, wh, axis=1)[:, :, col_idx]
        bias_r = r_start + jnp.arange(wh, dtype=jnp.int32) - r_q + (NA_WIN_H - 1)
        bias = rpb[:, bias_r[None, :, None], bias_c[:, None, :]]
        s_win = jnp.einsum('bchd,bicjhd->bhcij', q_row, k_win,
                           preferred_element_type=jnp.float32) * scale + bias.astype(jnp.float32)
        s_ctx = jnp.einsum('bchd,bshd->bhcs', q_row, k_ctx, preferred_element_type=jnp.float32) * scale
        s = jnp.concatenate([s_win.reshape(B, H, GRID_W, nw), s_ctx], axis=-1)
        p = jax.nn.softmax(s, axis=-1).astype(v.dtype)
        p_win = p[..., :nw].reshape(B, H, GRID_W, wh, NA_WIN_W)
        return (jnp.einsum('bhcij,bicjhd->bchd', p_win, v_win)
                + jnp.einsum('bhcs,bshd->bchd', p[..., nw:], v_ctx))

    o = lax.map(row_block, (qg, r, r0))
    return o.transpose(1, 0, 2, 3, 4).reshape(B, S, H * D)


def _short_conv(x, w):
    y = lax.conv_general_dilated(x, w[:, None, :].astype(x.dtype), window_strides=(1,),
                                 padding=[(CONV_K // 2, CONV_K // 2)],
                                 dimension_numbers=('NWC', 'WIO', 'NWC'),
                                 feature_group_count=x.shape[-1])
    return jax.nn.silu(y)


def _dn_qkv(qkv, conv_w):
    y = _short_conv(qkv, conv_w).astype(jnp.float32)
    q, k, v = jnp.split(y, 3, axis=-1)
    q = _l2norm(_heads(q, C_HEADS)) * HEAD_DIM ** -0.5
    k = _l2norm(_heads(k, C_HEADS))
    return q, k, _heads(v, C_HEADS)


def _dn_gates(ab, a_log, dt_bias):
    abf = ab.astype(jnp.float32).reshape(ab.shape[:-1] + (2, 2, C_HEADS))
    beta = jax.nn.sigmoid(abf[..., 0, :])
    g = -jnp.exp(a_log.astype(jnp.float32)) * jax.nn.softplus(abf[..., 1, :] + dt_bias.astype(jnp.float32))
    return beta, g


def _gdn_chunked(q, k, v, g, beta, s0):
    B, T, H, Dk = q.shape
    C = DN_CHUNK
    N = T // C

    def chunks(t):
        return t.reshape(B, N, C, H, t.shape[-1]).transpose(1, 0, 3, 2, 4)

    qc, kc, vc = chunks(q), chunks(k), chunks(v)
    gc = g.reshape(B, N, C, H).transpose(1, 0, 3, 2)
    bc = beta.reshape(B, N, C, H).transpose(1, 0, 3, 2)
    gcum = jnp.cumsum(gc, axis=-1)
    lower = jnp.tril(jnp.ones((C, C), bool))
    strict = jnp.tril(jnp.ones((C, C), bool), -1)
    diff = gcum[..., :, None] - gcum[..., None, :]
    decay = jnp.where(lower, jnp.exp(jnp.where(lower, diff, 0.0)), 0.0)
    kb = kc * bc[..., None]
    lmat = jnp.where(strict, jnp.einsum('nbhid,nbhjd->nbhij', kb, kc) * decay, 0.0)
    a = lmat + jnp.eye(C, dtype=jnp.float32)
    u = lax.linalg.triangular_solve(a, vc * bc[..., None], left_side=True, lower=True, unit_diagonal=True)
    w = lax.linalg.triangular_solve(a, kb * jnp.exp(gcum)[..., None], left_side=True, lower=True,
                                    unit_diagonal=True)
    qk = jnp.einsum('nbhid,nbhjd->nbhij', qc, kc) * decay

    def step(s, xs):
        q_i, k_i, u_i, w_i, g_i, qk_i = xs
        v_new = u_i - jnp.einsum('bhcd,bhde->bhce', w_i, s)
        o = (jnp.einsum('bhcd,bhde->bhce', q_i * jnp.exp(g_i)[..., None], s)
             + jnp.einsum('bhij,bhje->bhie', qk_i, v_new))
        g_last = g_i[..., -1:]
        s = s * jnp.exp(g_last)[..., None] + jnp.einsum(
            'bhcd,bhce->bhde', k_i * jnp.exp(g_last - g_i)[..., None], v_new)
        return s, o

    s_fin, o = lax.scan(step, s0, (qc, kc, u, w, gcum, qk))
    return o.transpose(1, 0, 3, 2, 4).reshape(B, T, H, v.shape[-1]), s_fin


def _bidir_gated_deltanet(qkv, qkv_x, ab, ab_x, conv_w, a_log, dt_bias, with_ctx_out):
    q, k, v = _dn_qkv(qkv, conv_w)
    q_x, k_x, v_x = _dn_qkv(qkv_x, conv_w)
    beta, g = _dn_gates(ab, a_log, dt_bias)
    beta_x, g_x = _dn_gates(ab_x, a_log, dt_bias)
    s0 = jnp.zeros((q.shape[0], C_HEADS, HEAD_DIM, HEAD_DIM), jnp.float32)

    def rev(t):
        return t[:, ::-1]

    oxf, sxf = _gdn_chunked(q_x, k_x, v_x, g_x[:, :, 0], beta_x[:, :, 0], s0)
    of, _ = _gdn_chunked(q, k, v, g[:, :, 0], beta[:, :, 0], sxf)
    oxb, sxb = _gdn_chunked(rev(q_x), rev(k_x), rev(v_x), rev(g_x[:, :, 1]), rev(beta_x[:, :, 1]), s0)
    ob, _ = _gdn_chunked(rev(q), rev(k), rev(v), rev(g[:, :, 1]), rev(beta[:, :, 1]), sxb)
    o_lat = of + rev(ob)
    o_ctx = oxf + rev(oxb) if with_ctx_out else None
    return o_lat, o_ctx


def _layer(x, ctx, mod_lat, mod_ctx, w_in, q_norm, k_norm, rpb, conv_w, a_log, dt_bias, o_norm,
           w_out, ln_g, ln_b, rope_cos, rope_sin, rows, with_ctx_out):
    B, S, _ = x.shape
    L = ctx.shape[1]
    shift, scale, gate = jnp.split(mod_lat, 3, axis=-1)
    shift_x, scale_x, gate_x = jnp.split(mod_ctx, 3, axis=-1)
    h = _layernorm(x) * (1 + scale[:, None, :]) + shift[:, None, :]
    hx = _layernorm(ctx) * (1 + scale_x) + shift_x
    qa, ka, va, za, qb, kb, vb, zb, qkv_c, zc, ab = _split_in(h @ w_in)
    qa_x, ka_x, va_x, za_x, qb_x, kb_x, vb_x, zb_x, qkv_cx, zc_x, ab_x = _split_in(hx @ w_in)

    qa = _apply_axial_rope(_rmsnorm(_heads(qa, A_HEADS), q_norm), rope_cos, rope_sin)
    ka = _apply_axial_rope(_rmsnorm(_heads(ka, A_KV_HEADS), k_norm), rope_cos, rope_sin)
    ka_x = _rmsnorm(_heads(ka_x, A_KV_HEADS), k_norm)
    va_x = _heads(va_x, A_KV_HEADS)
    ya = _grid_attention(qa, ka, _heads(va, A_KV_HEADS), ka_x, va_x) * jax.nn.silu(za)

    kb_x, vb_x = _heads(kb_x, B_HEADS), _heads(vb_x, B_HEADS)
    yb = _neighbourhood_attention(_heads(qb, B_HEADS), _heads(kb, B_HEADS), _heads(vb, B_HEADS),
                                  kb_x, vb_x, rpb, rows) * jax.nn.silu(zb)

    oc, oc_x = _bidir_gated_deltanet(qkv_c, qkv_cx, ab, ab_x, conv_w, a_log, dt_bias, with_ctx_out)
    yc = _rmsnorm(oc, o_norm).astype(h.dtype).reshape(B, S, C_W) * jax.nn.silu(zc)

    y = jnp.concatenate([ya, yb, yc], axis=-1) @ w_out
    x_new = _layernorm(ALPHA * x + gate[:, None, :] * y, ln_g, ln_b)
    if not with_ctx_out:
        return x_new, ctx

    qa_x = _rmsnorm(_heads(qa_x, A_HEADS), q_norm)
    ya_x = _dense_attention(qa_x, ka_x, va_x) * jax.nn.silu(za_x)
    yb_x = _dense_attention(_heads(qb_x, B_HEADS), kb_x, vb_x) * jax.nn.silu(zb_x)
    yc_x = _rmsnorm(oc_x, o_norm).astype(hx.dtype).reshape(B, L, C_W) * jax.nn.silu(zc_x)
    y_x = jnp.concatenate([ya_x, yb_x, yc_x], axis=-1) @ w_out
    ctx_new = _layernorm(ALPHA * ctx + gate_x * y_x, ln_g, ln_b)
    return x_new, ctx_new


def setup_inputs(seed: int = 0) -> dict:
    key = jax.random.key(seed)
    ks = jax.random.split(key, 17)
    nrm = jax.random.normal
    x = nrm(ks[0], (BATCH, SEQ, D_MODEL), jnp.float32)
    c = nrm(ks[1], (BATCH, D_MODEL), jnp.float32)
    ctx = nrm(ks[2], (BATCH, CTX_LEN, D_MODEL), jnp.float32)
    c_ctx = nrm(ks[3], (D_MODEL,), jnp.float32)
    w_mod = nrm(ks[4], (DEPTH, D_MODEL, 3 * D_MODEL), jnp.float32) * D_MODEL ** -0.5
    b_mod = 0.02 * nrm(ks[5], (DEPTH, 3 * D_MODEL), jnp.float32)
    w_in = nrm(ks[6], (DEPTH, D_MODEL, IN_W), jnp.float32) * D_MODEL ** -0.5
    q_norm = 1.0 + 0.02 * nrm(ks[7], (DEPTH, HEAD_DIM), jnp.float32)
    k_norm = 1.0 + 0.02 * nrm(ks[8], (DEPTH, HEAD_DIM), jnp.float32)
    rpb = 0.02 * nrm(ks[9], (DEPTH, B_HEADS, 2 * NA_WIN_H - 1, 2 * NA_WIN_W - 1), jnp.float32)
    conv_w = nrm(ks[10], (DEPTH, CONV_K, 3 * C_W), jnp.float32) * CONV_K ** -0.5
    a_log = jnp.log(jax.random.uniform(ks[11], (DEPTH, 2, C_HEADS), jnp.float32, 1.0, 16.0))
    u = jax.random.uniform(ks[12], (DEPTH, 2, C_HEADS), jnp.float32)
    dt = jnp.exp(u * (math.log(0.1) - math.log(0.001)) + math.log(0.001))
    dt_bias = dt + jnp.log(-jnp.expm1(-dt))
    o_norm = 1.0 + 0.02 * nrm(ks[13], (DEPTH, HEAD_DIM), jnp.float32)
    w_out = nrm(ks[14], (DEPTH, MIX_W, D_MODEL), jnp.float32) * (MIX_W ** -0.5 * OUT_INIT)
    ln_g = 1.0 + 0.02 * nrm(ks[15], (DEPTH, D_MODEL), jnp.float32)
    ln_b = 0.02 * nrm(ks[16], (DEPTH, D_MODEL), jnp.float32)
    return {'x': x, 'c': c, 'ctx': ctx, 'c_ctx': c_ctx, 'w_mod': w_mod, 'b_mod': b_mod,
            'w_in': w_in, 'q_norm': q_norm, 'k_norm': k_norm, 'rpb': rpb, 'conv_w': conv_w,
            'a_log': a_log, 'dt_bias': dt_bias, 'o_norm': o_norm, 'w_out': w_out,
            'ln_g': ln_g, 'ln_b': ln_b}


def reference(x, c, ctx, c_ctx, w_mod, b_mod, w_in, q_norm, k_norm, rpb, conv_w, a_log, dt_bias,
              o_norm, w_out, ln_g, ln_b):
    n_lat = x.shape[1]
    rows = n_lat // GRID_W
    rope_cos, rope_sin = _axial_rope_tables(n_lat)
    for l in range(DEPTH):
        mod_lat = jax.nn.silu(c) @ w_mod[l] + b_mod[l]
        mod_ctx = jax.nn.silu(c_ctx) @ w_mod[l] + b_mod[l]
        x, ctx = _layer(x, ctx, mod_lat, mod_ctx, w_in[l], q_norm[l], k_norm[l], rpb[l], conv_w[l],
                        a_log[l], dt_bias[l], o_norm[l], w_out[l], ln_g[l], ln_b[l],
                        rope_cos, rope_sin, rows, l < DEPTH - 1)
    return x
```

```cpp
#include <hip/hip_runtime.h>
#include <hip/hip_cooperative_groups.h>
#include <cstdio>
#include <cstdint>
namespace cg = cooperative_groups;

#define DI __device__ __forceinline__
typedef unsigned short bf16_t;
using bf16x8 = __attribute__((ext_vector_type(8))) short;
using s16x4  = __attribute__((ext_vector_type(4))) short;
using f32x4  = __attribute__((ext_vector_type(4))) float;
using f32x16 = __attribute__((ext_vector_type(16))) float;
using u32x4  = __attribute__((ext_vector_type(4))) unsigned;
using u32x2  = __attribute__((ext_vector_type(2))) unsigned;

constexpr int DM = 2048, NBATCH = 4, SEQ = 4096, CTX = 256, TPB = 4352  , MTOK = NBATCH * TPB;
constexpr int INW = 6672, NP = 6784  , HD = 128;
constexpr int C_QA = 0, C_KA = 1024, C_VA = 1280, C_ZA = 1536, C_QB = 2560, C_KB = 3072, C_VB = 3584, C_ZB = 4096, C_QC = 4608, C_ZC = 6144;
constexpr int NCH = 68;
constexpr float EPS = 1e-6f;
constexpr float ALPHA = 1.4142135623730951f;

constexpr size_t al256(size_t x) { return (x + 255) / 256 * 256; }
constexpr size_t WS_MOD  = 0;
constexpr size_t WS_CTR  = al256(WS_MOD + 2 * 5 * 6144 * 4);
constexpr size_t WS_WINT = WS_CTR + 256;
constexpr size_t WS_WOUT = al256(WS_WINT + (size_t)NP * DM * 2);
constexpr size_t WS_HC   = al256(WS_WOUT + (size_t)DM * DM * 2);
constexpr size_t WS_P    = al256(WS_HC + (size_t)MTOK * DM * 2);
constexpr size_t WS_GT   = al256(WS_P + (size_t)MTOK * NP * 2);
constexpr size_t WS_CTX1 = al256(WS_GT + (size_t)MTOK * 16 * 4);
constexpr size_t WS_OF   = al256(WS_CTX1 + (size_t)NBATCH * CTX * DM * 4);
constexpr size_t WS_OB   = al256(WS_OF + (size_t)MTOK * 512 * 2);
constexpr size_t WS_QN   = al256(WS_OB + (size_t)MTOK * 512 * 2);
constexpr size_t WS_KT   = al256(WS_QN + (size_t)16 * NCH * 64 * 128 * 2);
constexpr size_t WS_W    = al256(WS_KT + (size_t)16 * NCH * 64 * 128 * 2);
constexpr size_t WS_U    = al256(WS_W + (size_t)32 * NCH * 64 * 128 * 2);
constexpr size_t WS_QK   = al256(WS_U + (size_t)32 * NCH * 64 * 128 * 2);
constexpr size_t WS_GC   = al256(WS_QK + (size_t)32 * NCH * 64 * 64 * 2);
constexpr size_t WS_END  = al256(WS_GC + (size_t)32 * NCH * 136 * 4);

constexpr int LDS_BYTES = 144896;

struct Params {
  const float *x, *c, *ctx, *c_ctx, *w_mod, *b_mod, *w_in, *q_norm, *k_norm, *rpb, *conv_w, *a_log, *dt_bias, *o_norm, *w_out, *ln_g, *ln_b;
  float* out; char* ws;
  int ph_lo, ph_hi;
};

extern __shared__ __attribute__((aligned(16))) char smem[];

DI bf16_t f2bf(float x) { unsigned u = __float_as_uint(x); u += 0x7fffu + ((u >> 16) & 1u); return (bf16_t)(u >> 16); }
DI float bf2f(bf16_t v) { return __uint_as_float(((unsigned)v) << 16); }
DI unsigned pk2(float lo, float hi) { return (unsigned)f2bf(lo) | ((unsigned)f2bf(hi) << 16); }
DI float wave_sum(float v) { for (int o = 32; o; o >>= 1) v += __shfl_xor(v, o); return v; }
DI float silu_f(float v) { return v / (1.f + __expf(-v)); }
DI int invperm16(int off) { return 8 * ((off >> 2) & 1) + (off & 3) + 4 * (off >> 3); }
DI int perm_k(int k) { return (k & ~15) | invperm16(k & 15); }
DI int opaque_tid() { int t = threadIdx.x; asm volatile("" : "+v"(t)); return t; }
DI int crow(int r, int hi) { return (r & 3) + 8 * (r >> 2) + 4 * hi; }

DI void phase_mod(const Params& p) {
  const int tid = threadIdx.x;
  float* sc = (float*)smem;
  float* red = (float*)(smem + 40960);
  if (blockIdx.x == 0 && tid < 8) ((int*)(p.ws + WS_CTR))[tid] = 0;
  for (int i = tid; i < 5 * 2048; i += 512) { float v = i < 4 * 2048 ? p.c[i] : p.c_ctx[i - 4 * 2048]; sc[i] = silu_f(v); }
  __syncthreads();
  float* MOD = (float*)(p.ws + WS_MOD);
  for (int t = blockIdx.x; t < 192; t += gridDim.x) {
    const int layer = t / 96, cg0 = (t % 96) * 64;
    const int cl = tid & 15, ks = tid >> 4;
    const float* W = p.w_mod + (size_t)layer * DM * 6144 + cg0 + cl * 4;
    f32x4 a[5]; for (int r = 0; r < 5; ++r) a[r] = (f32x4){0.f, 0.f, 0.f, 0.f};
    for (int k = ks * 64; k < ks * 64 + 64; ++k) {
      const f32x4 w = *(const f32x4*)(W + (size_t)k * 6144);
#pragma unroll
      for (int r = 0; r < 5; ++r) a[r] += w * sc[r * 2048 + k];
    }
#pragma unroll
    for (int r = 0; r < 5; ++r) *(f32x4*)(red + (ks * 5 + r) * 64 + cl * 4) = a[r];
    __syncthreads();
    if (tid < 320) { const int r = tid >> 6, cc = tid & 63; float s = 0.f; for (int k2 = 0; k2 < 32; ++k2) s += red[(k2 * 5 + r) * 64 + cc];
      MOD[(layer * 5 + r) * 6144 + cg0 + cc] = s + p.b_mod[layer * 6144 + cg0 + cc]; }
    __syncthreads();
  }
}

DI void ln_stats(const f32x4 (&v)[8], float& mean, float& rstd) {
  float s = 0.f;
#pragma unroll
  for (int i = 0; i < 8; ++i) s += (v[i][0] + v[i][1]) + (v[i][2] + v[i][3]);
  s = wave_sum(s); mean = s * (1.f / 2048.f);
  float q = 0.f;
#pragma unroll
  for (int i = 0; i < 8; ++i) { f32x4 d = v[i] - mean; q += (d[0] * d[0] + d[1] * d[1]) + (d[2] * d[2] + d[3] * d[3]); }
  q = wave_sum(q); rstd = rsqrtf(q * (1.f / 2048.f) + EPS);
}

DI void phase_rows(const Params& p, int layer) {
  const int tid = threadIdx.x, wid = tid >> 6, lane = tid & 63;
  const float* MOD = (const float*)(p.ws + WS_MOD) + layer * 5 * 6144;
  bf16_t* H = (bf16_t*)(p.ws + WS_HC);
  float* CTX1 = (float*)(p.ws + WS_CTX1);
  for (int row = blockIdx.x * 8 + wid; row < MTOK; row += gridDim.x * 8) {
    const int b = row / TPB, tin = row % TPB; const bool isctx = tin < CTX;
    float* src;
    if (layer == 0) src = (float*)(isctx ? p.ctx + (size_t)(b * CTX + tin) * DM : p.x + (size_t)(b * SEQ + tin - CTX) * DM);
    else src = isctx ? CTX1 + (size_t)(b * CTX + tin) * DM : p.out + (size_t)(b * SEQ + tin - CTX) * DM;
    f32x4 v[8];
#pragma unroll
    for (int i = 0; i < 8; ++i) v[i] = *(const f32x4*)(src + i * 256 + lane * 4);
    float mean, rstd;
    if (layer > 0) {
      ln_stats(v, mean, rstd);
      const float* g = p.ln_g + (layer - 1) * DM; const float* bb = p.ln_b + (layer - 1) * DM;
#pragma unroll
      for (int i = 0; i < 8; ++i) { const f32x4 gg = *(const f32x4*)(g + i * 256 + lane * 4), b4 = *(const f32x4*)(bb + i * 256 + lane * 4);
        v[i] = (v[i] - mean) * rstd * gg + b4; *(f32x4*)(src + i * 256 + lane * 4) = v[i]; }
    }
    ln_stats(v, mean, rstd);
    const float* mr = MOD + (isctx ? 4 : b) * 6144;
#pragma unroll
    for (int i = 0; i < 8; ++i) { const int col = i * 256 + lane * 4;
      const f32x4 sh = *(const f32x4*)(mr + col), scl = *(const f32x4*)(mr + 2048 + col);
      const f32x4 h = (v[i] - mean) * rstd * (scl + 1.f) + sh;
      u32x2 w; w.x = pk2(h[0], h[1]); w.y = pk2(h[2], h[3]);
      *(u32x2*)(H + (size_t)row * DM + col) = w; }
  }
}

DI void phase_final_ln(const Params& p) {
  const int tid = threadIdx.x, wid = tid >> 6, lane = tid & 63;
  const float* g = p.ln_g + DM; const float* bb = p.ln_b + DM;
  for (int row = blockIdx.x * 8 + wid; row < NBATCH * SEQ; row += gridDim.x * 8) {
    float* src = p.out + (size_t)row * DM;
    f32x4 v[8];
#pragma unroll
    for (int i = 0; i < 8; ++i) v[i] = *(const f32x4*)(src + i * 256 + lane * 4);
    float mean, rstd; ln_stats(v, mean, rstd);
#pragma unroll
    for (int i = 0; i < 8; ++i) { const f32x4 gg = *(const f32x4*)(g + i * 256 + lane * 4), b4 = *(const f32x4*)(bb + i * 256 + lane * 4);
      *(f32x4*)(src + i * 256 + lane * 4) = (v[i] - mean) * rstd * gg + b4; }
  }
}

DI void convert_weight(const float* W, int N, int ntn, bf16_t* WT, int t) {
  const int tid = threadIdx.x;
  float* tile = (float*)smem;
  const int n0 = (t % ntn) * 64, k0 = (t / ntn) * 64;
  { const int kr = tid >> 4, c4 = (tid & 15) * 4;
#pragma unroll
    for (int pss = 0; pss < 2; ++pss) { const int k = kr + pss * 32;
      f32x4 w = (f32x4){0.f, 0.f, 0.f, 0.f};
      if (n0 + c4 < N) w = *(const f32x4*)(W + (size_t)(k0 + k) * N + n0 + c4);
      tile[k * 65 + c4] = w[0]; tile[k * 65 + c4 + 1] = w[1]; tile[k * 65 + c4 + 2] = w[2]; tile[k * 65 + c4 + 3] = w[3]; } }
  __syncthreads();
  { const int n = tid >> 3, k8 = (tid & 7) * 8;
    u32x4 w; w.x = pk2(tile[(k8 + 0) * 65 + n], tile[(k8 + 1) * 65 + n]); w.y = pk2(tile[(k8 + 2) * 65 + n], tile[(k8 + 3) * 65 + n]);
    w.z = pk2(tile[(k8 + 4) * 65 + n], tile[(k8 + 5) * 65 + n]); w.w = pk2(tile[(k8 + 6) * 65 + n], tile[(k8 + 7) * 65 + n]);
    *(u32x4*)(WT + (size_t)(n0 + n) * DM + k0 + k8) = w; }
  __syncthreads();
}
DI void phase_convert(const Params& p, int layer) {
  const int T1 = (NP / 64) * 32, T2 = 32 * 32;
  for (int t = blockIdx.x; t < T1 + T2; t += gridDim.x) {
    if (t < T1) convert_weight(p.w_in + (size_t)layer * DM * INW, INW, NP / 64, (bf16_t*)(p.ws + WS_WINT), t);
    else convert_weight(p.w_out + (size_t)layer * DM * DM, DM, 32, (bf16_t*)(p.ws + WS_WOUT), t - T1);
  }
}

DI int lds_byte(int r, int c) { const int st = (r >> 4) * 2 + (c >> 5), rr = r & 15, cc = c & 31, ob = rr * 64 + cc * 2; return st * 1024 + (ob ^ (((ob >> 9) & 1) << 5)); }
DI void stage_rc(int b, int& R, int& C) { const int st = b / 1024, sb = b % 1024, swz = sb ^ (((sb >> 9) & 1) << 5); R = (st >> 1) * 16 + swz / 64; C = (st & 1) * 32 + (swz % 64) / 2; }
constexpr int GSTAGE = 49152;

DI void gemm_stage(const bf16_t* A, const bf16_t* Bt, int row0, int col0, int kt, int buf) {
  char* base = smem + buf * GSTAGE;
#pragma unroll
  for (int i = 0; i < 2; ++i) { const int b = threadIdx.x * 16 + i * 8192; int R, C; stage_rc(b, R, C);
    __builtin_amdgcn_global_load_lds((const unsigned*)(A + (size_t)(row0 + R) * DM + kt * 64 + C), (unsigned*)(base + b), 16, 0, 0);
    __builtin_amdgcn_global_load_lds((const unsigned*)(A + (size_t)(row0 + 128 + R) * DM + kt * 64 + C), (unsigned*)(base + 16384 + b), 16, 0, 0);
    __builtin_amdgcn_global_load_lds((const unsigned*)(Bt + (size_t)(col0 + R) * DM + kt * 64 + C), (unsigned*)(base + 32768 + b), 16, 0, 0); }
}
DI void gemm_mainloop(const bf16_t* A, const bf16_t* Bt, int row0, int col0, f32x4 (&acc)[4][4]) {
  const int tid_ = opaque_tid(); const int wid = tid_ >> 6, lane = tid_ & 63, wr = wid >> 1, wc = wid & 1, fr = lane & 15, fq = lane >> 4;
#pragma unroll
  for (int m = 0; m < 4; ++m)
#pragma unroll
    for (int n = 0; n < 4; ++n) acc[m][n] = (f32x4){0.f, 0.f, 0.f, 0.f};
  gemm_stage(A, Bt, row0, col0, 0, 0);
  asm volatile("s_waitcnt vmcnt(0)" ::: "memory"); __syncthreads();
  constexpr int NT = DM / 64;
  for (int t = 0; t < NT; ++t) {
    if (t + 1 < NT) gemm_stage(A, Bt, row0, col0, t + 1, (t + 1) & 1);
    const char* base = smem + (t & 1) * GSTAGE;
    const char* ab = base + (wr >> 1) * 16384; const char* bb = base + 32768;
    bf16x8 af[4][2], bfr[4][2];
#pragma unroll
    for (int m = 0; m < 4; ++m)
#pragma unroll
      for (int k = 0; k < 2; ++k) af[m][k] = *(const bf16x8*)(ab + lds_byte((wr & 1) * 64 + m * 16 + fr, k * 32 + fq * 8));
#pragma unroll
    for (int n = 0; n < 4; ++n)
#pragma unroll
      for (int k = 0; k < 2; ++k) bfr[n][k] = *(const bf16x8*)(bb + lds_byte(wc * 64 + n * 16 + fr, k * 32 + fq * 8));
#pragma unroll
    for (int k = 0; k < 2; ++k)
#pragma unroll
      for (int m = 0; m < 4; ++m)
#pragma unroll
        for (int n = 0; n < 4; ++n) acc[m][n] = __builtin_amdgcn_mfma_f32_16x16x32_bf16(af[m][k], bfr[n][k], acc[m][n], 0, 0, 0);
    asm volatile("s_waitcnt vmcnt(0)" ::: "memory"); __syncthreads();
  }
}

DI void phase_gemm1(const Params& p, int layer) {
  const bf16_t* A = (const bf16_t*)(p.ws + WS_HC); const bf16_t* Bt = (const bf16_t*)(p.ws + WS_WINT);
  bf16_t* P = (bf16_t*)(p.ws + WS_P); float* GT = (float*)(p.ws + WS_GT);
  float* exch = (float*)(smem + 2 * GSTAGE);
  constexpr int NTN = NP / 128, NTM = MTOK / 256;
  for (int t = blockIdx.x; t < NTN * NTM; t += gridDim.x) {
    const int pn = t % NTN, pm = t / NTN;
    f32x4 acc[4][4];
    gemm_mainloop(A, Bt, pm * 256, pn * 128, acc);
    const int tid_ = opaque_tid(); const int wid = tid_ >> 6, lane = tid_ & 63, wr = wid >> 1, wc = wid & 1, fr = lane & 15, fq = lane >> 4;
    const int rowb = pm * 256 + wr * 64;
    if (pn < 10) {
#pragma unroll
      for (int m = 0; m < 4; ++m)
#pragma unroll
        for (int j = 0; j < 4; ++j) { float ss = 0.f;
#pragma unroll
          for (int n = 0; n < 4; ++n) ss += acc[m][n][j] * acc[m][n][j];
          ss += __shfl_xor(ss, 1); ss += __shfl_xor(ss, 2); ss += __shfl_xor(ss, 4); ss += __shfl_xor(ss, 8);
          if (fr == 0) exch[(wr * 64 + m * 16 + fq * 4 + j) * 2 + wc] = ss; }
      __syncthreads();
      const float* gw = (pn < 8 ? p.q_norm : p.k_norm) + layer * HD + wc * 64;
      float g[4];
#pragma unroll
      for (int n = 0; n < 4; ++n) g[n] = gw[n * 16 + fr];
      float invf[2];
#pragma unroll
      for (int n = 0; n < 2; ++n) invf[n] = exp2f(-(float)(n * 16 + fr) * (13.287712379549449f / 32.f));
#pragma unroll
      for (int m = 0; m < 4; ++m)
#pragma unroll
        for (int j = 0; j < 4; ++j) { const int rl = wr * 64 + m * 16 + fq * 4 + j, row = pm * 256 + rl;
          const float rstd = rsqrtf((exch[rl * 2] + exch[rl * 2 + 1]) * (1.f / 128.f) + EPS);
          const int tin = row % TPB; const bool lat = tin >= CTX; const int s = tin - CTX;
          const float pos = (float)(wc == 0 ? (s >> 6) : (s & 63));
          bf16_t* dst = P + (size_t)row * NP + pn * 128 + wc * 64 + fr;
#pragma unroll
          for (int n = 0; n < 2; ++n) { float x1 = acc[m][n][j] * rstd * g[n], x2 = acc[m][n + 2][j] * rstd * g[n + 2];
            if (lat) { float sn, cs; __sincosf(pos * invf[n], &sn, &cs); const float o1 = x1 * cs - x2 * sn, o2 = x2 * cs + x1 * sn; x1 = o1; x2 = o2; }
            dst[n * 16] = f2bf(x1); dst[(n + 2) * 16] = f2bf(x2); } }
      __syncthreads();
    } else if (pn == 52) {
      if (wc == 0) {
#pragma unroll
        for (int m = 0; m < 4; ++m)
#pragma unroll
          for (int j = 0; j < 4; ++j) GT[(size_t)(rowb + m * 16 + fq * 4 + j) * 16 + fr] = acc[m][0][j];
      }
    } else {
      const bool sl = (pn >= 12 && pn < 20) || (pn >= 32 && pn < 36) || (pn >= 48 && pn < 52);
#pragma unroll
      for (int m = 0; m < 4; ++m)
#pragma unroll
        for (int j = 0; j < 4; ++j) { bf16_t* dst = P + (size_t)(rowb + m * 16 + fq * 4 + j) * NP + pn * 128 + wc * 64 + fr;
#pragma unroll
          for (int n = 0; n < 4; ++n) { float v = acc[m][n][j]; if (sl) v = silu_f(v); dst[n * 16] = f2bf(v); } }
    }
  }
}

DI void phase_gemm2(const Params& p, int layer) {
  const bf16_t* A = (const bf16_t*)(p.ws + WS_HC); const bf16_t* Bt = (const bf16_t*)(p.ws + WS_WOUT);
  const float* MOD = (const float*)(p.ws + WS_MOD) + layer * 5 * 6144;
  float* CTX1 = (float*)(p.ws + WS_CTX1);
  constexpr int NTN = DM / 128, NTM = MTOK / 256;
  for (int t = blockIdx.x; t < NTN * NTM; t += gridDim.x) {
    const int pn = t % NTN, pm = t / NTN;
    const int b = pm / 17, tb = pm % 17; const bool isctx = tb == 0;
    if (isctx && layer == 1) continue;
    f32x4 acc[4][4];
    gemm_mainloop(A, Bt, pm * 256, pn * 128, acc);
    const int tid_ = opaque_tid(); const int wid = tid_ >> 6, lane = tid_ & 63, wr = wid >> 1, wc = wid & 1, fr = lane & 15, fq = lane >> 4;
    const float* gate = MOD + (isctx ? 4 : b) * 6144 + 4096 + pn * 128 + wc * 64 + fr;
#pragma unroll
    for (int m = 0; m < 4; ++m)
#pragma unroll
      for (int j = 0; j < 4; ++j) { const int rin = wr * 64 + m * 16 + fq * 4 + j;
        const size_t cbase = (size_t)pn * 128 + wc * 64 + fr;
        const float* xr; float* dst;
        if (isctx) { const size_t o = (size_t)(b * CTX + rin) * DM + cbase; xr = p.ctx + o; dst = CTX1 + o; }
        else { const size_t o = (size_t)(b * SEQ + (tb - 1) * 256 + rin) * DM + cbase; xr = (layer == 0 ? p.x : p.out) + o; dst = p.out + o; }
#pragma unroll
        for (int n = 0; n < 4; ++n) dst[n * 16] = ALPHA * xr[n * 16] + gate[n * 16] * acc[m][n][j]; }
  }
}

constexpr int KVBLK = 64;
constexpr float SCALE = 0.088388347648318440f;
constexpr float THR = 8.f;
constexpr size_t SHM_V = KVBLK * HD * 2, SHM_K = KVBLK * HD * 2;
#define KSWZ(row, colB) ((row) * 256 + ((colB) ^ (((row) & 7) << 4)))
#define SBAR() __builtin_amdgcn_sched_barrier(0)
DI unsigned cvtpk(float lo, float hi) { unsigned r; asm volatile("v_cvt_pk_bf16_f32 %0, %1, %2" : "=v"(r) : "v"(lo), "v"(hi)); return r; }

DI void partialSM(f32x16& p0, f32x16& p1, float& m_reg, float& mn, float& alpha) {
  constexpr float C = SCALE * 1.4426950408889634f;
  float pmax = p0[0];
#pragma unroll
  for (int r = 1; r < 16; ++r) pmax = fmaxf(pmax, p0[r]);
#pragma unroll
  for (int r = 0; r < 16; ++r) pmax = fmaxf(pmax, p1[r]);
  { auto rr = __builtin_amdgcn_permlane32_swap(__float_as_uint(pmax), __float_as_uint(pmax), false, false);
    pmax = fmaxf(__uint_as_float(rr[0]), __uint_as_float(rr[1])); }
  if (__builtin_expect(__all(pmax - m_reg <= THR / SCALE), 1)) { mn = m_reg; alpha = 1.f; }
  else { mn = fmaxf(m_reg, pmax); alpha = __builtin_amdgcn_exp2f((m_reg - mn) * C); m_reg = mn; }
  float mnC = -mn * C;
#pragma unroll
  for (int r = 0; r < 16; ++r) p0[r] = fmaf(p0[r], C, mnC);
#pragma unroll
  for (int r = 0; r < 16; ++r) p1[r] = fmaf(p1[r], C, mnC);
#pragma unroll
  for (int r = 0; r < 16; ++r) p0[r] = __builtin_amdgcn_exp2f(p0[r]);
}
DI void finishSM(f32x16& p0, f32x16& p1, float alpha, float& l_reg, bf16x8& pa0, bf16x8& pa1, bf16x8& pa2, bf16x8& pa3) {
#pragma unroll
  for (int r = 0; r < 16; ++r) p1[r] = __builtin_amdgcn_exp2f(p1[r]);
  float ps = 0;
#pragma unroll
  for (int r = 0; r < 16; ++r) ps += p0[r];
#pragma unroll
  for (int r = 0; r < 16; ++r) ps += p1[r];
  { auto rr = __builtin_amdgcn_permlane32_swap(__float_as_uint(ps), __float_as_uint(ps), false, false);
    ps = __uint_as_float(rr[0]) + __uint_as_float(rr[1]); }
  l_reg = l_reg * alpha + ps;
#define PK4(P, BASE, OUT) do { unsigned a0 = cvtpk(P[BASE + 0], P[BASE + 1]), a1 = cvtpk(P[BASE + 2], P[BASE + 3]);   \
    unsigned b0 = cvtpk(P[BASE + 4], P[BASE + 5]), b1 = cvtpk(P[BASE + 6], P[BASE + 7]);                              \
    auto r0 = __builtin_amdgcn_permlane32_swap(a0, b0, false, false); auto r1 = __builtin_amdgcn_permlane32_swap(a1, b1, false, false); \
    u32x4 w = {r0[0], r1[0], r0[1], r1[1]}; OUT = *reinterpret_cast<bf16x8*>(&w); } while (0)
  PK4(p0, 0, pa0); PK4(p0, 8, pa1); PK4(p1, 0, pa2); PK4(p1, 8, pa3);
#undef PK4
}
DI void qkt(f32x16& p0, f32x16& p1, const char* Ks, const bf16x8* qr, int r32, int hi) {
  p0 = f32x16{}; p1 = f32x16{};
#pragma unroll
  for (int d0 = 0; d0 < 8; ++d0) { int cb = (d0 * 16 + hi * 8) * 2;
    bf16x8 b0 = *reinterpret_cast<const bf16x8*>(Ks + KSWZ(r32, cb));
    bf16x8 b1 = *reinterpret_cast<const bf16x8*>(Ks + KSWZ(32 + r32, cb));
    p0 = __builtin_amdgcn_mfma_f32_32x32x16_bf16(b0, qr[d0], p0, 0, 0, 0);
    p1 = __builtin_amdgcn_mfma_f32_32x32x16_bf16(b1, qr[d0], p1, 0, 0, 0); }
}
DI int v_st(int k, int c) { const int kk = (k & ~0xC) | ((k & 4) << 1) | ((k & 8) >> 1); return ((kk >> 3) * 4 + (c >> 5)) * 512 + ((kk & 7) * 32 + (c & 31)) * 2; }
DI int v_rd_base(int lane) { return ((lane & 3) << 3) | (((lane >> 2) & 3) << 6) | (((lane >> 4) & 1) << 5) | (((lane >> 5) & 1) << 8); }
constexpr int v_rd_off(int d0, int ks, int half) { return d0 * 512 + ks * 4096 + half * 2048; }
template <int OFF> DI s16x4 tr_read(int vb) {
  s16x4 r; asm volatile("ds_read_b64_tr_b16 %0, %1 offset:%2" : "=&v"(r) : "v"(vb), "i"(OFF) : "memory"); return r;
}
template <int D0> DI void pv_one(f32x16& od, int vb, bf16x8 pa0, bf16x8 pa1, bf16x8 pa2, bf16x8 pa3) {
  const s16x4 l0 = tr_read<v_rd_off(D0, 0, 0)>(vb), h0 = tr_read<v_rd_off(D0, 0, 1)>(vb), l1 = tr_read<v_rd_off(D0, 1, 0)>(vb), h1 = tr_read<v_rd_off(D0, 1, 1)>(vb);
  const s16x4 l2 = tr_read<v_rd_off(D0, 2, 0)>(vb), h2 = tr_read<v_rd_off(D0, 2, 1)>(vb), l3 = tr_read<v_rd_off(D0, 3, 0)>(vb), h3 = tr_read<v_rd_off(D0, 3, 1)>(vb);
  asm volatile("s_waitcnt lgkmcnt(0)" ::: "memory"); SBAR();
#define PKV(L, H) (bf16x8){L[0], L[1], L[2], L[3], H[0], H[1], H[2], H[3]}
  od = __builtin_amdgcn_mfma_f32_32x32x16_bf16(pa0, PKV(l0, h0), od, 0, 0, 0);
  od = __builtin_amdgcn_mfma_f32_32x32x16_bf16(pa1, PKV(l1, h1), od, 0, 0, 0);
  od = __builtin_amdgcn_mfma_f32_32x32x16_bf16(pa2, PKV(l2, h2), od, 0, 0, 0);
  od = __builtin_amdgcn_mfma_f32_32x32x16_bf16(pa3, PKV(l3, h3), od, 0, 0, 0);
#undef PKV
}
DI void pv_d0(f32x16* o, int vb, bf16x8 pa0, bf16x8 pa1, bf16x8 pa2, bf16x8 pa3) {
  pv_one<0>(o[0], vb, pa0, pa1, pa2, pa3); pv_one<1>(o[1], vb, pa0, pa1, pa2, pa3); pv_one<2>(o[2], vb, pa0, pa1, pa2, pa3); pv_one<3>(o[3], vb, pa0, pa1, pa2, pa3);
}

DI void na_apply(f32x16& p0, f32x16& p1, int rk, int rq, int cq, const float* rpb_h, int hi) {
  const int r0 = min(max(rq - 4, 0), 56), c0 = min(max(cq - 8, 0), 48);
  const bool rowok = rk >= r0 && rk < r0 + 8;
  const float* bp = rpb_h + (rk - rq + 7) * 31 + 15 - cq;
#pragma unroll
  for (int r = 0; r < 16; ++r) { const int ck = crow(r, hi); const bool ok = rowok && ck >= c0 && ck < c0 + 16;
    float bias = 0.f; if (ok) bias = bp[ck]; p0[r] = ok ? p0[r] + bias * (1.f / SCALE) : -1e30f; }
#pragma unroll
  for (int r = 0; r < 16; ++r) { const int ck = 32 + crow(r, hi); const bool ok = rowok && ck >= c0 && ck < c0 + 16;
    float bias = 0.f; if (ok) bias = bp[ck]; p1[r] = ok ? p1[r] + bias * (1.f / SCALE) : -1e30f; }
}

template <bool NA, int SD>
DI void attn_body(const bf16_t* __restrict__ Qb, const bf16_t* __restrict__ Kb, const bf16_t* __restrict__ Vb, const bf16_t* __restrict__ Zb,
                  bf16_t* __restrict__ Ob, int NT, int rlo, int rq0, const float* rpb_h) {
  char* lds = smem;
  const int tid = opaque_tid(), wid = tid >> 6, lane = tid & 63, r32 = lane & 31, hi = lane >> 5;
  char* V_lds = lds; char* K_lds = lds + 2 * SHM_V;
  float* wsx = (float*)(lds + 2 * SHM_V + 2 * SHM_K) + wid * 64; float* li_l = wsx; float* al_l = wsx + 32;
  float m_reg = -1e30f, l_reg = 0; f32x16 o[4] = {}; bf16x8 qr[8];
  const bf16_t* Qw = Qb + (size_t)(wid * 32 + r32) * NP + hi * 8;
#pragma unroll
  for (int d0 = 0; d0 < 8; ++d0) qr[d0] = *(const bf16x8*)(Qw + d0 * 16);
  const int sr = tid >> 4, sc = (tid & 15) * 8, vst0 = v_st(sr, sc), vst1 = v_st(32 + sr, sc);
  const int vb0 = (int)(uintptr_t)V_lds + v_rd_base(lane);
  const int rq = rq0 + (wid >> 1), cq = (wid & 1) * 32 + r32;
  struct { bf16x8 vs0, vs1, ks0, ks1; } sr_[SD];
#define TROW(j) (NA ? ((j) < 4 ? (j) * 64 : CTX + (rlo + (j) - 4) * 64) : (j) * 64)
#define SLOAD(i, j) do { const size_t k0_ = (size_t)TROW(j); sr_[i].vs0 = *(const bf16x8*)(&Vb[(k0_ + sr) * NP + sc]); sr_[i].vs1 = *(const bf16x8*)(&Vb[(k0_ + 32 + sr) * NP + sc]); \
    sr_[i].ks0 = *(const bf16x8*)(&Kb[(k0_ + sr) * NP + sc]); sr_[i].ks1 = *(const bf16x8*)(&Kb[(k0_ + 32 + sr) * NP + sc]); } while (0)
#define SWRITE(b, i) do { *(bf16x8*)(V_lds + (b) * SHM_V + vst0) = sr_[i].vs0;          \
    *(bf16x8*)(V_lds + (b) * SHM_V + vst1) = sr_[i].vs1; int kc = sc * 2;               \
    *(bf16x8*)(K_lds + (b) * SHM_K + KSWZ(sr, kc)) = sr_[i].ks0;                       \
    *(bf16x8*)(K_lds + (b) * SHM_K + KSWZ(32 + sr, kc)) = sr_[i].ks1; } while (0)
#define SWAIT() do { if constexpr (SD == 2) asm volatile("s_waitcnt vmcnt(4)" ::: "memory"); else asm volatile("s_waitcnt vmcnt(0)" ::: "memory"); } while (0)
#define RESC(a) do { if (__any((a) < 1.f)) { if (hi == 0) al_l[r32] = (a); asm volatile("s_waitcnt lgkmcnt(0)" ::: "memory"); \
    for (int d = 0; d < 4; ++d) for (int r = 0; r < 16; ++r) o[d][r] *= al_l[crow(r, hi)]; } } while (0)
#define NAMASK(PA, PB, j) do { if (NA && (j) >= 4) na_apply(PA, PB, rlo + (j) - 4, rq, cq, rpb_h, hi); } while (0)
  f32x16 pA0, pA1, pB0, pB1; float mnA, mnB, alA, alB; bf16x8 pa0, pa1, pa2, pa3;
  constexpr int SE = 0, SO = SD - 1;
  SLOAD(SE, 0); asm volatile("s_waitcnt vmcnt(0)" ::: "memory"); SWRITE(0, SE); __syncthreads();
  qkt(pA0, pA1, K_lds, qr, r32, hi); NAMASK(pA0, pA1, 0); partialSM(pA0, pA1, m_reg, mnA, alA);
  SLOAD(SO, 1); if constexpr (SD == 2) { if (2 < NT) SLOAD(SE, 2); }
  SWAIT(); SWRITE(1, SO); __syncthreads();
  for (int j = 1; j + 1 < NT; j += 2) {
    SBAR(); qkt(pB0, pB1, K_lds + SHM_K, qr, r32, hi); NAMASK(pB0, pB1, j);
    finishSM(pA0, pA1, alA, l_reg, pa0, pa1, pa2, pa3); SBAR();
    SLOAD(SO, j + SD); SBAR();
    pv_d0(o, vb0, pa0, pa1, pa2, pa3); partialSM(pB0, pB1, m_reg, mnB, alB);
    __syncthreads(); SWAIT(); SWRITE(0, SE);
    RESC(alB); __syncthreads();
    SBAR(); qkt(pA0, pA1, K_lds, qr, r32, hi); NAMASK(pA0, pA1, j + 1);
    finishSM(pB0, pB1, alB, l_reg, pa0, pa1, pa2, pa3); SBAR();
    if (SD == 1 || j + 3 < NT) SLOAD(SE, j + 1 + SD); SBAR();
    pv_d0(o, vb0 + (int)SHM_V, pa0, pa1, pa2, pa3); partialSM(pA0, pA1, m_reg, mnA, alA);
    __syncthreads(); SWAIT(); SWRITE(1, SO);
    RESC(alA); __syncthreads();
  }
  SBAR(); qkt(pB0, pB1, K_lds + SHM_K, qr, r32, hi); NAMASK(pB0, pB1, NT - 1);
  finishSM(pA0, pA1, alA, l_reg, pa0, pa1, pa2, pa3); SBAR();
  pv_d0(o, vb0, pa0, pa1, pa2, pa3); partialSM(pB0, pB1, m_reg, mnB, alB);
  __syncthreads(); RESC(alB);
  finishSM(pB0, pB1, alB, l_reg, pa0, pa1, pa2, pa3); SBAR();
  pv_d0(o, vb0 + (int)SHM_V, pa0, pa1, pa2, pa3);
  if (hi == 0) li_l[r32] = l_reg; asm volatile("s_waitcnt lgkmcnt(0)" ::: "memory");
  float rli[16];
#pragma unroll
  for (int r = 0; r < 16; ++r) rli[r] = __builtin_amdgcn_rcpf(li_l[crow(r, hi)]);
  bf16_t* Ow = Ob + (size_t)(wid * 32) * DM; const bf16_t* Zw = Zb + (size_t)(wid * 32) * NP;
#pragma unroll
  for (int r = 0; r < 16; ++r) { const int orow = crow(r, hi);
#pragma unroll
    for (int d0 = 0; d0 < 4; ++d0) { const float gz = bf2f(Zw[(size_t)orow * NP + d0 * 32 + r32]);
      Ow[(size_t)orow * DM + d0 * 32 + r32] = f2bf(o[d0][r] * rli[r] * gz); } }
#undef SLOAD
#undef SWRITE
#undef SWAIT
#undef RESC
#undef NAMASK
#undef TROW
}

constexpr int PL_QS = 0, PL_KS = 17408, PL_VT = 34816, PL_KTT = 53248, PL_LM = 71680, PL_TU = 106496, PL_TW = 124928, PL_G = 143360;
DI void dn_prep(const Params& p, int layer, int task) {
  const int tid = opaque_tid(), wid = tid >> 6, lane = tid & 63, fr = lane & 15, fq = lane >> 4;
  const int bh = task / NCH, ch = task % NCH, b = bh >> 2, h = bh & 3;
  const size_t tok0 = (size_t)b * TPB + ch * 64;
  const bool has_left = !(ch == 0 || ch == 4), has_right = !(ch == 3 || ch == NCH - 1);
  const bf16_t* P = (const bf16_t*)(p.ws + WS_P); const float* GT = (const float*)(p.ws + WS_GT);
  bf16_t* qs = (bf16_t*)(smem + PL_QS); bf16_t* ks = (bf16_t*)(smem + PL_KS); bf16_t* vT = (bf16_t*)(smem + PL_VT); bf16_t* kT = (bf16_t*)(smem + PL_KTT);
  float* Lm = (float*)(smem + PL_LM); bf16_t* Tu = (bf16_t*)(smem + PL_TU); bf16_t* Tw = (bf16_t*)(smem + PL_TW);
  float* gbeta = (float*)(smem + PL_G); float* ggc = gbeta + 128; float* geg = gbeta + 256;
  bf16_t* QN = (bf16_t*)(p.ws + WS_QN) + (size_t)(bh * NCH + ch) * 64 * 128;
  bf16_t* KTg = (bf16_t*)(p.ws + WS_KT) + (size_t)(bh * NCH + ch) * 128 * 64;

  if (wid < 2) { const int dir = wid;
    const float* gr = GT + (tok0 + lane) * 16 + dir * 8;
    const float beta = 1.f / (1.f + __expf(-gr[h]));
    const float a = gr[4 + h] + p.dt_bias[layer * 8 + dir * 4 + h];
    const float sp = a > 20.f ? a : log1pf(__expf(a));
    float x = -__expf(p.a_log[layer * 8 + dir * 4 + h]) * sp;
    if (dir == 0) { for (int o = 1; o < 64; o <<= 1) { float t = __shfl_up(x, o); if (lane >= o) x += t; } }
    else { for (int o = 1; o < 64; o <<= 1) { float t = __shfl_down(x, o); if (lane + o < 64) x += t; } }
    const float glast = __shfl(x, dir == 0 ? 63 : 0);
    const float eg = __expf(x);
    gbeta[dir * 64 + lane] = beta; ggc[dir * 64 + lane] = x; geg[dir * 64 + lane] = eg;
    float* GC = (float*)(p.ws + WS_GC) + (size_t)((bh * 2 + dir) * NCH + ch) * 136;
    GC[lane] = eg; GC[64 + lane] = __expf(glast - x); if (lane == 0) GC[128] = __expf(glast);
  }
  SBAR();
#pragma unroll 1
  for (int i = 0; i < 6; ++i) { const int it = tid + i * 512, which = it >> 10, rem = it & 1023, c = rem >> 4, d8 = (rem & 15) * 8;
    const int col = C_QC + which * 512 + h * 128 + d8;
    const bf16_t* pr = P + (tok0 + c) * NP + col;
    bf16x8 x0 = *(const bf16x8*)pr, xm = (bf16x8){0, 0, 0, 0, 0, 0, 0, 0}, xp = xm;
    if (c > 0 || has_left) xm = *(const bf16x8*)(pr - NP);
    if (c < 63 || has_right) xp = *(const bf16x8*)(pr + NP);
    const float* cw = p.conv_w + (size_t)layer * 3 * 1536 + which * 512 + h * 128 + d8;
    float y[8]; float ss = 0.f;
#pragma unroll
    for (int e = 0; e < 8; ++e) { float v = cw[e] * bf2f((bf16_t)xm[e]) + cw[1536 + e] * bf2f((bf16_t)x0[e]) + cw[3072 + e] * bf2f((bf16_t)xp[e]);
      v = silu_f(v); y[e] = v; ss += v * v; }
    if (which < 2) { ss += __shfl_xor(ss, 1); ss += __shfl_xor(ss, 2); ss += __shfl_xor(ss, 4); ss += __shfl_xor(ss, 8);
      const float rn = rsqrtf(ss + EPS) * (which == 0 ? 0.088388347648318440f : 1.f);
#pragma unroll
      for (int e = 0; e < 8; ++e) y[e] *= rn; }
    if (which == 0) { u32x4 w = {pk2(y[0], y[1]), pk2(y[2], y[3]), pk2(y[4], y[5]), pk2(y[6], y[7])};
      *(u32x4*)(qs + c * 136 + d8) = w;
      bf16_t* qd = QN + c * 128 + (d8 & ~15);
      if ((d8 & 15) == 0) { *(u32x2*)(qd + 0) = (u32x2){w.x, w.y}; *(u32x2*)(qd + 8) = (u32x2){w.z, w.w}; }
      else { *(u32x2*)(qd + 4) = (u32x2){w.x, w.y}; *(u32x2*)(qd + 12) = (u32x2){w.z, w.w}; }
    } else if (which == 1) { u32x4 w = {pk2(y[0], y[1]), pk2(y[2], y[3]), pk2(y[4], y[5]), pk2(y[6], y[7])};
      *(u32x4*)(ks + c * 136 + d8) = w;
      const int cp = perm_k(c);
#pragma unroll
      for (int e = 0; e < 8; ++e) { const bf16_t kv = f2bf(y[e]); kT[(d8 + e) * 72 + c] = kv; KTg[(d8 + e) * 64 + cp] = kv; }
    } else {
#pragma unroll
      for (int e = 0; e < 8; ++e) vT[(d8 + e) * 72 + c] = f2bf(y[e]);
    }
  }
  __syncthreads();
  SBAR();
  { const int sel = wid >> 2, mi = wid & 3;
    const bf16_t* Ar = (sel == 0 ? ks : qs) + (mi * 16 + fr) * 136 + fq * 8;
    f32x4 acc[4];
#pragma unroll
    for (int n = 0; n < 4; ++n) acc[n] = (f32x4){0.f, 0.f, 0.f, 0.f};
#pragma unroll
    for (int kk = 0; kk < 4; ++kk) { const bf16x8 a = *(const bf16x8*)(Ar + kk * 32);
#pragma unroll
      for (int n = 0; n < 4; ++n) { const bf16x8 bb = *(const bf16x8*)(ks + (n * 16 + fr) * 136 + kk * 32 + fq * 8);
        acc[n] = __builtin_amdgcn_mfma_f32_16x16x32_bf16(a, bb, acc[n], 0, 0, 0); } }
    bf16_t* QKg = (bf16_t*)(p.ws + WS_QK);
#pragma unroll
    for (int n = 0; n < 4; ++n)
#pragma unroll
      for (int j = 0; j < 4; ++j) { const int i = mi * 16 + fq * 4 + j, jj = n * 16 + fr; const float val = acc[n][j];
#pragma unroll
        for (int dir = 0; dir < 2; ++dir) { const float e = __expf(fminf(ggc[dir * 64 + i] - ggc[dir * 64 + jj], 0.f));
          if (sel == 0) { const bool ok = dir == 0 ? (i > jj) : (i < jj); const float lv = ok ? gbeta[dir * 64 + i] * val * e : 0.f;
            const int i2 = dir == 0 ? i : 63 - i, j2 = dir == 0 ? jj : 63 - jj; Lm[(dir * 64 + i2) * 68 + j2] = lv; }
          else { const bool ok = dir == 0 ? (i >= jj) : (i <= jj);
            QKg[((size_t)((bh * 2 + dir) * NCH + ch) * 64 + i) * 64 + perm_k(jj)] = f2bf(ok ? val * e : 0.f); } } }
  }
  __syncthreads();
  SBAR();
  if (wid < 2) { const int dir = wid; const float* Lr = Lm + dir * 64 * 68;
    float t[64];
#pragma unroll
    for (int i = 0; i < 64; ++i) t[i] = 0.f;
#pragma unroll
    for (int i = 0; i < 64; ++i) { float a = (i == lane) ? 1.f : 0.f;
#pragma unroll
      for (int j4 = 0; j4 < (i + 3) / 4; ++j4) { const f32x4 l = *(const f32x4*)(Lr + i * 68 + j4 * 4);
        a -= l[0] * t[j4 * 4]; a -= l[1] * t[j4 * 4 + 1]; a -= l[2] * t[j4 * 4 + 2]; a -= l[3] * t[j4 * 4 + 3]; }
      t[i] = a; Lm[(dir * 64 + i) * 68 + lane] = a; __builtin_amdgcn_sched_barrier(0); }
  }
  __syncthreads();
  SBAR();
#pragma unroll 1
  for (int i = 0; i < 16; ++i) { const int idx = tid + i * 512, dir = idx >> 12, i2 = (idx >> 6) & 63, j2 = idx & 63;
    const float tv = Lm[(dir * 64 + i2) * 68 + j2];
    const int ir = dir == 0 ? i2 : 63 - i2, jc = dir == 0 ? j2 : 63 - j2;
    const float bj = gbeta[dir * 64 + jc];
    Tu[(dir * 64 + ir) * 72 + jc] = f2bf(tv * bj); Tw[(dir * 64 + ir) * 72 + jc] = f2bf(tv * bj * geg[dir * 64 + jc]); }
  __syncthreads();
  SBAR();
  { const int mat = wid >> 1, nh = wid & 1, dir = mat & 1, isw = mat >> 1;
    const bf16_t* Am = (isw ? Tw : Tu) + dir * 64 * 72; const bf16_t* Bm = isw ? kT : vT;
    f32x4 acc[4][4];
#pragma unroll
    for (int m = 0; m < 4; ++m)
#pragma unroll
      for (int n = 0; n < 4; ++n) acc[m][n] = (f32x4){0.f, 0.f, 0.f, 0.f};
#pragma unroll
    for (int kk = 0; kk < 2; ++kk) { bf16x8 a[4], bb[4];
#pragma unroll
      for (int m = 0; m < 4; ++m) a[m] = *(const bf16x8*)(Am + (m * 16 + fr) * 72 + kk * 32 + fq * 8);
#pragma unroll
      for (int n = 0; n < 4; ++n) bb[n] = *(const bf16x8*)(Bm + ((nh * 4 + n) * 16 + fr) * 72 + kk * 32 + fq * 8);
#pragma unroll
      for (int m = 0; m < 4; ++m)
#pragma unroll
        for (int n = 0; n < 4; ++n) acc[m][n] = __builtin_amdgcn_mfma_f32_16x16x32_bf16(a[m], bb[n], acc[m][n], 0, 0, 0); }
    const size_t cb = (size_t)((bh * 2 + dir) * NCH + ch);
    bf16_t* Ul = (bf16_t*)(p.ws + WS_U) + cb * 64 * 128 + nh * 4096 + fr * 16 + (fq & 1) * 512 + (fq >> 1) * 4;
    bf16_t* Wl = (bf16_t*)(p.ws + WS_W) + cb * 64 * 128 + fq * 512 + nh * 64 + invperm16(fr);
    if (isw) {
#pragma unroll
      for (int m = 0; m < 4; ++m)
#pragma unroll
        for (int n = 0; n < 4; ++n)
#pragma unroll
          for (int j = 0; j < 4; ++j) Wl[(m * 16 + j) * 128 + n * 16] = f2bf(-acc[m][n][j]);
    } else {
#pragma unroll
      for (int m = 0; m < 4; ++m)
#pragma unroll
        for (int n = 0; n < 4; ++n) { u32x2 w = {pk2(acc[m][n][0], acc[m][n][1]), pk2(acc[m][n][2], acc[m][n][3])};
          *(u32x2*)(Ul + (n >> 1) * 2048 + (m >> 1) * 1024 + (n & 1) * 256 + 8 * (m & 1)) = w; }
    }
  }
  __syncthreads();
}

DI bf16x8 pack8(const f32x16& x, int s) {
  u32x4 w = {pk2(x[8 * s], x[8 * s + 1]), pk2(x[8 * s + 2], x[8 * s + 3]), pk2(x[8 * s + 4], x[8 * s + 5]), pk2(x[8 * s + 6], x[8 * s + 7])};
  return __builtin_bit_cast(bf16x8, w);
}
#define MFMA32(a, b, c) __builtin_amdgcn_mfma_f32_32x32x16_bf16((a), (b), (c), 0, 0, 0)
DI void dn_scan_wave(const Params& p, int bh, int dir, int eb) {
  const int lane = opaque_tid() & 63, r = lane & 31, hh = lane >> 5;
  const int b = bh >> 2, h = bh & 3;
  f32x16 S[4];
#pragma unroll
  for (int d = 0; d < 4; ++d) S[d] = f32x16{};
  bf16_t* Og = (bf16_t*)(p.ws + (dir == 0 ? WS_OF : WS_OB));
#pragma unroll 1
  for (int step = 0; step < NCH; ++step) {
    const int ch = dir == 0 ? step : (step < 4 ? 3 - step : 71 - step);
    const size_t cb = (size_t)((bh * 2 + dir) * NCH + ch), cq = (size_t)(bh * NCH + ch);
    const bf16_t* Wg = (const bf16_t*)(p.ws + WS_W) + cb * 8192; const bf16_t* Ug = (const bf16_t*)(p.ws + WS_U) + cb * 8192;
    const bf16_t* QKg = (const bf16_t*)(p.ws + WS_QK) + cb * 4096; const float* GC = (const float*)(p.ws + WS_GC) + cb * 136;
    const bf16_t* QNg = (const bf16_t*)(p.ws + WS_QN) + cq * 8192; const bf16_t* KTg = (const bf16_t*)(p.ws + WS_KT) + cq * 8192;
    bf16x8 Sp[8];
#pragma unroll
    for (int d = 0; d < 4; ++d) { Sp[2 * d] = pack8(S[d], 0); Sp[2 * d + 1] = pack8(S[d], 1); }
    f32x16 VN[2], O[2];
#pragma unroll
    for (int ct = 0; ct < 2; ++ct) { const bf16_t* up = Ug + ((eb * 2 + ct) * 64 + lane) * 16;
      const bf16x8 u0 = *(const bf16x8*)up, u1 = *(const bf16x8*)(up + 8);
#pragma unroll
      for (int i = 0; i < 8; ++i) { VN[ct][i] = bf2f((bf16_t)u0[i]); VN[ct][8 + i] = bf2f((bf16_t)u1[i]); }
      O[ct] = f32x16{}; }
#pragma unroll
    for (int ct = 0; ct < 2; ++ct)
#pragma unroll
      for (int ks = 0; ks < 8; ++ks) { const bf16x8 a = *(const bf16x8*)(Wg + (ct * 32 + r) * 128 + ks * 16 + hh * 8); VN[ct] = MFMA32(a, Sp[ks], VN[ct]); if (ks == 7) SBAR(); }
#pragma unroll
    for (int ct = 0; ct < 2; ++ct)
#pragma unroll
      for (int ks = 0; ks < 8; ++ks) { const bf16x8 a = *(const bf16x8*)(QNg + (ct * 32 + r) * 128 + ks * 16 + hh * 8); O[ct] = MFMA32(a, Sp[ks], O[ct]); if (ks == 7) SBAR(); }
#pragma unroll
    for (int ct = 0; ct < 2; ++ct)
#pragma unroll
      for (int q4 = 0; q4 < 4; ++q4) { const f32x4 eg = *(const f32x4*)(GC + ct * 32 + 8 * q4 + 4 * hh);
#pragma unroll
        for (int i = 0; i < 4; ++i) O[ct][q4 * 4 + i] *= eg[i]; }
    bf16x8 Vp[4];
#pragma unroll
    for (int ct = 0; ct < 2; ++ct) { Vp[2 * ct] = pack8(VN[ct], 0); Vp[2 * ct + 1] = pack8(VN[ct], 1); }
#pragma unroll
    for (int ct = 0; ct < 2; ++ct)
#pragma unroll
      for (int ks = 0; ks < 4; ++ks) { const bf16x8 a = *(const bf16x8*)(QKg + (ct * 32 + r) * 64 + ks * 16 + hh * 8); O[ct] = MFMA32(a, Vp[ks], O[ct]); if (ks == 3) SBAR(); }
    { bf16_t* od = Og + ((size_t)b * TPB + ch * 64) * 512 + h * 128 + eb * 32 + r;
#pragma unroll
      for (int ct = 0; ct < 2; ++ct)
#pragma unroll
        for (int i = 0; i < 16; ++i) od[(size_t)(ct * 32 + crow(i, hh)) * 512] = f2bf(O[ct][i]); }
#pragma unroll
    for (int ct = 0; ct < 2; ++ct)
#pragma unroll
      for (int q4 = 0; q4 < 4; ++q4) { const f32x4 ek = *(const f32x4*)(GC + 64 + ct * 32 + 8 * q4 + 4 * hh);
#pragma unroll
        for (int i = 0; i < 4; ++i) VN[ct][q4 * 4 + i] *= ek[i]; }
#pragma unroll
    for (int ct = 0; ct < 2; ++ct) { Vp[2 * ct] = pack8(VN[ct], 0); Vp[2 * ct + 1] = pack8(VN[ct], 1); }
    const float egl = GC[128];
#pragma unroll
    for (int d = 0; d < 4; ++d) {
#pragma unroll
      for (int i = 0; i < 16; ++i) S[d][i] *= egl;
#pragma unroll
      for (int ks = 0; ks < 4; ++ks) { const bf16x8 a = *(const bf16x8*)(KTg + (d * 32 + r) * 64 + ks * 16 + hh * 8); S[d] = MFMA32(a, Vp[ks], S[d]); }
      SBAR(); }
  }
}

DI void phase_mix(const Params& p, int layer) {
  const int tid = threadIdx.x, wid = tid >> 6;
  if (blockIdx.x < 16) dn_scan_wave(p, blockIdx.x, wid >> 2, wid & 3);
  int* ctr = (int*)(p.ws + WS_CTR) + layer;
  int* s_unit = (int*)(smem + LDS_BYTES - 16);
  const bf16_t* P = (const bf16_t*)(p.ws + WS_P); bf16_t* CC = (bf16_t*)(p.ws + WS_HC);
  const int total = layer == 0 ? 816 : 768;
  for (;;) {
    __syncthreads();
    if (tid == 0) *s_unit = atomicAdd(ctr, 1);
    __syncthreads();
    const int u = *s_unit;
    if (u >= total) break;
    const bf16_t *Qp, *Kp, *Vp, *Zp; bf16_t* Op; int NT = 4, rlo = 0, rq0 = 0; const float* rp = nullptr; bool na = false;
    if (u < 512) { const int qb = u & 15, h = (u >> 4) & 7, b = u >> 7; const size_t t0 = (size_t)b * TPB, q0 = t0 + CTX + qb * 256;
      Qp = P + q0 * NP + C_QA + h * 128; Kp = P + t0 * NP + C_KA + (h >> 2) * 128; Vp = P + t0 * NP + C_VA + (h >> 2) * 128; Zp = P + q0 * NP + C_ZA + h * 128;
      Op = CC + q0 * DM + h * 128; NT = TPB / 64;
    } else if (u < 768) { const int v = u - 512, qb = v & 15, h = (v >> 4) & 3, b = v >> 6; const size_t t0 = (size_t)b * TPB, q0 = t0 + CTX + qb * 256;
      rq0 = qb * 4; rlo = min(max(rq0 - 4, 0), 52); na = true; NT = 16; rp = p.rpb + (size_t)(layer * 4 + h) * 15 * 31;
      Qp = P + q0 * NP + C_QB + h * 128; Kp = P + t0 * NP + C_KB + h * 128; Vp = P + t0 * NP + C_VB + h * 128; Zp = P + q0 * NP + C_ZB + h * 128;
      Op = CC + q0 * DM + 1024 + h * 128;
    } else if (u < 800) { const int v = u - 768, h = v & 7, b = v >> 3; const size_t t0 = (size_t)b * TPB;
      Qp = P + t0 * NP + C_QA + h * 128; Kp = P + t0 * NP + C_KA + (h >> 2) * 128; Vp = P + t0 * NP + C_VA + (h >> 2) * 128; Zp = P + t0 * NP + C_ZA + h * 128;
      Op = CC + t0 * DM + h * 128;
    } else { const int v = u - 800, h = v & 3, b = v >> 2; const size_t t0 = (size_t)b * TPB;
      Qp = P + t0 * NP + C_QB + h * 128; Kp = P + t0 * NP + C_KB + h * 128; Vp = P + t0 * NP + C_VB + h * 128; Zp = P + t0 * NP + C_ZB + h * 128;
      Op = CC + t0 * DM + 1024 + h * 128;
    }
    if (na) attn_body<true, 1>(Qp, Kp, Vp, Zp, Op, NT, rlo, rq0, rp);
    else attn_body<false, 1>(Qp, Kp, Vp, Zp, Op, NT, 0, 0, nullptr);
  }
}

DI void phase_yc(const Params& p, int layer) {
  const bf16_t* OF = (const bf16_t*)(p.ws + WS_OF); const bf16_t* OB = (const bf16_t*)(p.ws + WS_OB);
  const bf16_t* P = (const bf16_t*)(p.ws + WS_P); bf16_t* CC = (bf16_t*)(p.ws + WS_HC);
  const float* on = p.o_norm + layer * HD;
  const int l16 = threadIdx.x & 15;
  for (int it = blockIdx.x * 32 + (threadIdx.x >> 4); it < MTOK * 4; it += gridDim.x * 32) {
    const int tok = it >> 2, h = it & 3; const size_t o = (size_t)tok * 512 + h * 128 + l16 * 8;
    const bf16x8 a = *(const bf16x8*)(OF + o), bq = *(const bf16x8*)(OB + o);
    const bf16x8 z = *(const bf16x8*)(P + (size_t)tok * NP + C_ZC + h * 128 + l16 * 8);
    float y[8]; float ss = 0.f;
#pragma unroll
    for (int e = 0; e < 8; ++e) { y[e] = bf2f((bf16_t)a[e]) + bf2f((bf16_t)bq[e]); ss += y[e] * y[e]; }
    ss += __shfl_xor(ss, 1); ss += __shfl_xor(ss, 2); ss += __shfl_xor(ss, 4); ss += __shfl_xor(ss, 8);
    const float rs = rsqrtf(ss * (1.f / 128.f) + EPS);
#pragma unroll
    for (int e = 0; e < 8; ++e) y[e] = y[e] * rs * on[l16 * 8 + e] * bf2f((bf16_t)z[e]);
    u32x4 w = {pk2(y[0], y[1]), pk2(y[2], y[3]), pk2(y[4], y[5]), pk2(y[6], y[7])};
    *(u32x4*)(CC + (size_t)tok * DM + 1536 + h * 128 + l16 * 8) = w;
  }
}

template <int LAYER>
DI void layer_phases(const Params& p, cg::grid_group& grid) {
  constexpr int B0 = 1 + 6 * LAYER;
#define PH_ON(k) (p.ph_lo <= (k) && (k) <= p.ph_hi)
#define PH_SYNC(k) do { if (p.ph_lo <= (k) && (k) < p.ph_hi) grid.sync(); } while (0)
  if (PH_ON(B0 + 0)) { phase_rows(p, LAYER); phase_convert(p, LAYER); }
  PH_SYNC(B0 + 0);
  if (PH_ON(B0 + 1)) phase_gemm1(p, LAYER);
  PH_SYNC(B0 + 1);
  if (PH_ON(B0 + 2)) { for (int t = blockIdx.x; t < 16 * NCH; t += gridDim.x) dn_prep(p, LAYER, t); }
  PH_SYNC(B0 + 2);
  if (PH_ON(B0 + 3)) phase_mix(p, LAYER);
  PH_SYNC(B0 + 3);
  if (PH_ON(B0 + 4)) phase_yc(p, LAYER);
  PH_SYNC(B0 + 4);
  if (PH_ON(B0 + 5)) phase_gemm2(p, LAYER);
  PH_SYNC(B0 + 5);
}
__global__ void __launch_bounds__(512) fwd_megakernel(Params p) {
  cg::grid_group grid = cg::this_grid();
  if (PH_ON(0)) phase_mod(p);
  PH_SYNC(0);
  layer_phases<0>(p, grid);
  layer_phases<1>(p, grid);
  if (PH_ON(13)) phase_final_ln(p);
}

extern "C" void kernel_launch(void* const* d_in, const int* in_sizes, int n_in, void* d_out, int out_size, void* d_ws, size_t ws_size, hipStream_t stream) {
  static int grid_blocks = 0;
  if (!grid_blocks) {
    if (ws_size < WS_END) { fprintf(stderr, "kernel_launch: workspace too small: %zu < %zu\n", ws_size, (size_t)WS_END); return; }
    if (hipFuncSetAttribute((const void*)fwd_megakernel, hipFuncAttributeMaxDynamicSharedMemorySize, LDS_BYTES) != hipSuccess) { fprintf(stderr, "kernel_launch: LDS attribute failed\n"); return; }
    int dev = 0, cus = 0, per_cu = 0;
    hipGetDevice(&dev);
    hipDeviceGetAttribute(&cus, hipDeviceAttributeMultiprocessorCount, dev);
    hipOccupancyMaxActiveBlocksPerMultiprocessor(&per_cu, fwd_megakernel, 512, LDS_BYTES);
    if (per_cu < 1) { fprintf(stderr, "kernel_launch: occupancy query returned %d\n", per_cu); return; }
    grid_blocks = cus;
  }
  Params p{};
  p.x = (const float*)d_in[0]; p.c = (const float*)d_in[1]; p.ctx = (const float*)d_in[2]; p.c_ctx = (const float*)d_in[3];
  p.w_mod = (const float*)d_in[4]; p.b_mod = (const float*)d_in[5]; p.w_in = (const float*)d_in[6]; p.q_norm = (const float*)d_in[7];
  p.k_norm = (const float*)d_in[8]; p.rpb = (const float*)d_in[9]; p.conv_w = (const float*)d_in[10]; p.a_log = (const float*)d_in[11];
  p.dt_bias = (const float*)d_in[12]; p.o_norm = (const float*)d_in[13]; p.w_out = (const float*)d_in[14]; p.ln_g = (const float*)d_in[15]; p.ln_b = (const float*)d_in[16];
  p.out = (float*)d_out; p.ws = (char*)d_ws; p.ph_lo = 0; p.ph_hi = 13;
  void* args[] = {&p};
  hipError_t e = hipLaunchCooperativeKernel((void*)fwd_megakernel, dim3(grid_blocks), dim3(512), args, LDS_BYTES, stream);
  if (e != hipSuccess) fprintf(stderr, "cooperative launch failed: %s (grid %d)\n", hipGetErrorString(e), grid_blocks);
}
```

```cpp
#include <hip/hip_runtime.h>
#include <hip/hip_cooperative_groups.h>
#include <cstdio>
#include <cstdint>
namespace cg = cooperative_groups;

#define DI __device__ __forceinline__
typedef unsigned short bf16_t;
using bf16x8 = __attribute__((ext_vector_type(8))) short;
using s16x4  = __attribute__((ext_vector_type(4))) short;
using f32x4  = __attribute__((ext_vector_type(4))) float;
using f32x16 = __attribute__((ext_vector_type(16))) float;
using u32x4  = __attribute__((ext_vector_type(4))) unsigned;
using u32x2  = __attribute__((ext_vector_type(2))) unsigned;

constexpr int DM = 2048, NBATCH = 4, SEQ = 4096, CTX = 256, TPB = 4352  , MTOK = NBATCH * TPB;
constexpr int INW = 6672, NP = 6784  , NPW = 6656  , HD = 128;
constexpr int C_QA = 0, C_KA = 1024, C_VA = 1280, C_ZA = 1536, C_QB = 2560, C_KB = 3072, C_VB = 3584, C_ZB = 4096, C_QC = 4608, C_ZC = 6144;
constexpr int NCH = 68;
constexpr float EPS = 1e-6f;
constexpr float ALPHA = 1.4142135623730951f;

constexpr size_t al256(size_t x) { return (x + 255) / 256 * 256; }
constexpr size_t WS_MOD  = 0;
constexpr size_t WS_CTR  = al256(WS_MOD + 2 * 5 * 6144 * 4);
constexpr size_t WS_BAR  = WS_CTR + 256;
constexpr size_t WS_WINT = al256(WS_BAR + 3456 * 4);
constexpr size_t WS_WG   = al256(WS_WINT + (size_t)NPW * DM * 2);
constexpr size_t WS_WOUT = al256(WS_WG + (size_t)64 * DM * 2);
constexpr size_t WS_HC   = al256(WS_WOUT + (size_t)DM * DM * 2);
constexpr size_t WS_P    = al256(WS_HC + (size_t)MTOK * DM * 2);
constexpr size_t WS_GT   = al256(WS_P + (size_t)MTOK * NP * 2);
constexpr size_t WS_CTX1 = al256(WS_GT + (size_t)MTOK * 16 * 4);
constexpr size_t WS_OF   = al256(WS_CTX1 + (size_t)NBATCH * CTX * DM * 4);
constexpr size_t WS_OB   = al256(WS_OF + (size_t)MTOK * 512 * 2);
constexpr size_t WS_QN   = al256(WS_OB + (size_t)MTOK * 512 * 2);
constexpr size_t WS_KT   = al256(WS_QN + (size_t)16 * NCH * 64 * 128 * 2);
constexpr size_t WS_W    = al256(WS_KT + (size_t)16 * NCH * 64 * 128 * 2);
constexpr size_t WS_U    = al256(WS_W + (size_t)32 * NCH * 64 * 128 * 2);
constexpr size_t WS_QK   = al256(WS_U + (size_t)32 * NCH * 64 * 128 * 2);
constexpr size_t WS_GC   = al256(WS_QK + (size_t)32 * NCH * 64 * 64 * 2);
constexpr size_t WS_END  = al256(WS_GC + (size_t)32 * NCH * 136 * 4);

constexpr int LDS_BYTES = 150016;

struct Params {
  const float *x, *c, *ctx, *c_ctx, *w_mod, *b_mod, *w_in, *q_norm, *k_norm, *rpb, *conv_w, *a_log, *dt_bias, *o_norm, *w_out, *ln_g, *ln_b;
  float* out; char* ws;
  int ph_lo, ph_hi;
};

extern __shared__ __attribute__((aligned(16))) char smem[];

DI bf16_t f2bf(float x) { unsigned u = __float_as_uint(x); u += 0x7fffu + ((u >> 16) & 1u); return (bf16_t)(u >> 16); }
DI float bf2f(bf16_t v) { return __uint_as_float(((unsigned)v) << 16); }
typedef __bf16 bf16v2 __attribute__((ext_vector_type(2)));
typedef float f32v2 __attribute__((ext_vector_type(2)));
DI unsigned pk2(float lo, float hi) { f32v2 v = {lo, hi}; return __builtin_bit_cast(unsigned, __builtin_convertvector(v, bf16v2)); }
DI float wave_sum(float v) { for (int o = 32; o; o >>= 1) v += __shfl_xor(v, o); return v; }
DI float silu_f(float v) { return v / (1.f + __expf(-v)); }
DI int invperm16(int off) { return 8 * ((off >> 2) & 1) + (off & 3) + 4 * (off >> 3); }
DI int perm_k(int k) { return (k & ~15) | invperm16(k & 15); }
DI int opaque_tid() { int t = threadIdx.x; asm volatile("" : "+v"(t)); return t; }
DI size_t pidx(int hidx, size_t tok) { return ((size_t)hidx * MTOK + tok) * 128; }
DI int crow(int r, int hi) { return (r & 3) + 8 * (r >> 2) + 4 * hi; }

DI void phase_mod(const Params& p) {
  const int tid = threadIdx.x;
  float* sc = (float*)smem;
  float* red = (float*)(smem + 40960);
  if (blockIdx.x == 0 && tid < 8) ((int*)(p.ws + WS_CTR))[tid] = 0;
  for (int i = tid; i < 5 * 2048; i += 512) { float v = i < 4 * 2048 ? p.c[i] : p.c_ctx[i - 4 * 2048]; sc[i] = silu_f(v); }
  __syncthreads();
  float* MOD = (float*)(p.ws + WS_MOD);
  for (int t = blockIdx.x; t < 192; t += gridDim.x) {
    const int layer = t / 96, cg0 = (t % 96) * 64;
    const int cl = tid & 15, ks = tid >> 4;
    const float* W = p.w_mod + (size_t)layer * DM * 6144 + cg0 + cl * 4;
    f32x4 a[5]; for (int r = 0; r < 5; ++r) a[r] = (f32x4){0.f, 0.f, 0.f, 0.f};
    for (int k = ks * 64; k < ks * 64 + 64; ++k) {
      const f32x4 w = *(const f32x4*)(W + (size_t)k * 6144);
#pragma unroll
      for (int r = 0; r < 5; ++r) a[r] += w * sc[r * 2048 + k];
    }
#pragma unroll
    for (int r = 0; r < 5; ++r) *(f32x4*)(red + (ks * 5 + r) * 64 + cl * 4) = a[r];
    __syncthreads();
    if (tid < 320) { const int r = tid >> 6, cc = tid & 63; float s = 0.f; for (int k2 = 0; k2 < 32; ++k2) s += red[(k2 * 5 + r) * 64 + cc];
      MOD[(layer * 5 + r) * 6144 + cg0 + cc] = s + p.b_mod[layer * 6144 + cg0 + cc]; }
    __syncthreads();
  }
}

DI void ln_stats(const f32x4 (&v)[8], float& mean, float& rstd) {
  float s = 0.f;
#pragma unroll
  for (int i = 0; i < 8; ++i) s += (v[i][0] + v[i][1]) + (v[i][2] + v[i][3]);
  s = wave_sum(s); mean = s * (1.f / 2048.f);
  float q = 0.f;
#pragma unroll
  for (int i = 0; i < 8; ++i) { f32x4 d = v[i] - mean; q += (d[0] * d[0] + d[1] * d[1]) + (d[2] * d[2] + d[3] * d[3]); }
  q = wave_sum(q); rstd = rsqrtf(q * (1.f / 2048.f) + EPS);
}

DI void phase_rows(const Params& p, int layer) {
  const int tid = threadIdx.x, wid = tid >> 6, lane = tid & 63;
  const float* MOD = (const float*)(p.ws + WS_MOD) + layer * 5 * 6144;
  bf16_t* H = (bf16_t*)(p.ws + WS_HC);
  float* CTX1 = (float*)(p.ws + WS_CTX1);
  for (int row = blockIdx.x * 8 + wid; row < MTOK; row += gridDim.x * 8) {
    const int b = row / TPB, tin = row % TPB; const bool isctx = tin < CTX;
    const float* src = isctx ? p.ctx + (size_t)(b * CTX + tin) * DM : p.x + (size_t)(b * SEQ + tin - CTX) * DM;
    f32x4 v[8];
#pragma unroll
    for (int i = 0; i < 8; ++i) v[i] = *(const f32x4*)(src + i * 256 + lane * 4);
    float mean, rstd;
    if (layer > 0) {
      const bf16_t* yr = (const bf16_t*)(p.ws + WS_P) + (size_t)row * DM;
      float* dst = isctx ? CTX1 + (size_t)(b * CTX + tin) * DM : p.out + (size_t)(b * SEQ + tin - CTX) * DM;
#pragma unroll
      for (int i = 0; i < 8; ++i) { const u32x2 yw = *(const u32x2*)(yr + i * 256 + lane * 4);
        const f32x4 yv = {__uint_as_float(yw.x << 16), __uint_as_float(yw.x & 0xffff0000u), __uint_as_float(yw.y << 16), __uint_as_float(yw.y & 0xffff0000u)};
        v[i] = v[i] * ALPHA + yv; }
      ln_stats(v, mean, rstd);
      const float* g = p.ln_g + (layer - 1) * DM; const float* bb = p.ln_b + (layer - 1) * DM;
#pragma unroll
      for (int i = 0; i < 8; ++i) { const f32x4 gg = *(const f32x4*)(g + i * 256 + lane * 4), b4 = *(const f32x4*)(bb + i * 256 + lane * 4);
        v[i] = (v[i] - mean) * rstd * gg + b4; *(f32x4*)(dst + i * 256 + lane * 4) = v[i]; }
    }
    ln_stats(v, mean, rstd);
    const float* mr = MOD + (isctx ? 4 : b) * 6144;
#pragma unroll
    for (int i = 0; i < 8; ++i) { const int col = i * 256 + lane * 4;
      const f32x4 sh = *(const f32x4*)(mr + col), scl = *(const f32x4*)(mr + 2048 + col);
      const f32x4 h = (v[i] - mean) * rstd * (scl + 1.f) + sh;
      u32x2 w; w.x = pk2(h[0], h[1]); w.y = pk2(h[2], h[3]);
      *(u32x2*)(H + (size_t)row * DM + col) = w; }
  }
}

DI void phase_final_ln(const Params& p) {
  const int tid = threadIdx.x, wid = tid >> 6, lane = tid & 63;
  const float* g = p.ln_g + DM; const float* bb = p.ln_b + DM;
  for (int row = blockIdx.x * 8 + wid; row < NBATCH * SEQ; row += gridDim.x * 8) {
    float* src = p.out + (size_t)row * DM;
    const bf16_t* yr = (const bf16_t*)(p.ws + WS_P) + ((size_t)(row / SEQ) * TPB + CTX + row % SEQ) * DM;
    f32x4 v[8];
#pragma unroll
    for (int i = 0; i < 8; ++i) { const u32x2 yw = *(const u32x2*)(yr + i * 256 + lane * 4);
      const f32x4 yv = {__uint_as_float(yw.x << 16), __uint_as_float(yw.x & 0xffff0000u), __uint_as_float(yw.y << 16), __uint_as_float(yw.y & 0xffff0000u)};
      v[i] = *(const f32x4*)(src + i * 256 + lane * 4) * ALPHA + yv; }
    float mean, rstd; ln_stats(v, mean, rstd);
#pragma unroll
    for (int i = 0; i < 8; ++i) { const f32x4 gg = *(const f32x4*)(g + i * 256 + lane * 4), b4 = *(const f32x4*)(bb + i * 256 + lane * 4);
      *(f32x4*)(src + i * 256 + lane * 4) = (v[i] - mean) * rstd * gg + b4; }
  }
}

DI void convert_weight(const float* W, int N, int ntn, bf16_t* WT, int t, int nbase) {
  const int tid = threadIdx.x;
  float* tile = (float*)smem;
  const int n0 = nbase + (t % ntn) * 64, k0 = (t / ntn) * 64;
  { const int kr = tid >> 4, c4 = (tid & 15) * 4;
#pragma unroll
    for (int pss = 0; pss < 2; ++pss) { const int k = kr + pss * 32;
      f32x4 w = (f32x4){0.f, 0.f, 0.f, 0.f};
      if (n0 + c4 < N) w = *(const f32x4*)(W + (size_t)(k0 + k) * N + n0 + c4);
      tile[k * 65 + c4] = w[0]; tile[k * 65 + c4 + 1] = w[1]; tile[k * 65 + c4 + 2] = w[2]; tile[k * 65 + c4 + 3] = w[3]; } }
  __syncthreads();
  { const int n = tid >> 3, k8 = (tid & 7) * 8;
    u32x4 w; w.x = pk2(tile[(k8 + 0) * 65 + n], tile[(k8 + 1) * 65 + n]); w.y = pk2(tile[(k8 + 2) * 65 + n], tile[(k8 + 3) * 65 + n]);
    w.z = pk2(tile[(k8 + 4) * 65 + n], tile[(k8 + 5) * 65 + n]); w.w = pk2(tile[(k8 + 6) * 65 + n], tile[(k8 + 7) * 65 + n]);
    *(u32x4*)(WT + (size_t)(n0 - nbase + n) * DM + k0 + k8) = w; }
  __syncthreads();
}
DI void phase_convert(const Params& p, int layer) {
  const int T1 = (NPW / 64) * 32, T2 = 32 * 32, T3 = 32;
  for (int t = blockIdx.x; t < T1 + T2 + T3; t += gridDim.x) {
    if (t < T1) convert_weight(p.w_in + (size_t)layer * DM * INW, INW, NPW / 64, (bf16_t*)(p.ws + WS_WINT), t, 0);
    else if (t < T1 + T2) convert_weight(p.w_out + (size_t)layer * DM * DM, DM, 32, (bf16_t*)(p.ws + WS_WOUT), t - T1, 0);
    else convert_weight(p.w_in + (size_t)layer * DM * INW, INW, 1, (bf16_t*)(p.ws + WS_WG), t - T1 - T2, NPW);
  }
}

namespace pg8 {
#define PG8_LAS __attribute__((address_space(3)))
typedef unsigned short bf16_t;
typedef short bf16x8 __attribute__((ext_vector_type(8)));
typedef float f32x4 __attribute__((ext_vector_type(4)));
typedef unsigned u32x4 __attribute__((ext_vector_type(4)));
constexpr int BM = 256, BK = 64, HALF = 128, HTB = HALF * BK * 2  , STAGE_BYTES = 8 * HTB, NXCD = 8, WGM = 8;

__host__ __device__ __forceinline__ int lds_byte(int r, int c) { const int st = (r >> 4) * 2 + (c >> 5), rr = r & 15, cc = c & 31, ob = rr * 64 + cc * 2; return st * 1024 + (ob ^ (((ob >> 9) & 1) << 5)); }
__host__ __device__ __forceinline__ void stage_rc(int b, int& R, int& C) { const int st = b / 1024, sb = b % 1024, swz = sb ^ (((sb >> 9) & 1) << 5); R = (st >> 1) * 16 + swz / 64; C = (st & 1) * 32 + (swz % 64) / 2; }
__host__ __device__ __forceinline__ int perm32(int rho) { const int n = rho >> 4, i = rho & 15; return 8 * (i >> 2) + 4 * n + (i & 3); }

struct Unit { int pm, pn; };
struct Gemm { const bf16_t* A; const bf16_t* Bt; int M, N, K; };

struct StaticOrder {
    int nM, nN, nwg, G, c;
    __host__ __device__ void init(int M, int N, int G_, int c_) { nM = M / BM; nN = N / BM; nwg = nM * nN; G = G_; c = c_; }
    __host__ __device__ bool next(int i, Unit& u) const {
        const long L = (long)i * G + c; if (L >= nwg) return false;
        int wgid = (int)L; { const int q = nwg / NXCD, r = nwg % NXCD, xcd = wgid % NXCD, off = wgid / NXCD; wgid = (xcd < r ? xcd * (q + 1) : r * (q + 1) + (xcd - r) * q) + off; }
        const int nig = WGM * nN, gid = wgid / nig, fm = gid * WGM, gsz = (nM - fm) < WGM ? (nM - fm) : WGM;
        u.pm = fm + ((wgid % nig) % gsz); u.pn = (wgid % nig) / gsz; return true;
    }
    __device__ __forceinline__ void a_ready(const Unit&) const {}
    __device__ __forceinline__ void done(const Unit&) const {}
};

template <class Epi, class Sched, bool STAMP = false>
__device__ __forceinline__ void gemm_phase(PG8_LAS unsigned char* lds, const Gemm g, const Sched& S, const Epi& E, unsigned long long* stamps) {
    const int tid = threadIdx.x, wid = __builtin_amdgcn_readfirstlane(tid >> 6), lane = tid & 63, wr = wid >> 2, wc = wid & 3, fr = lane & 15, fq = lane >> 4;
    const int K = g.K, nt = K / BK;
    int ts_lo = 0, ts_hi = 0, nts = 0; const unsigned long long rt_entry = STAMP ? (unsigned long long)wall_clock64() : 0ull;
#define PG8_STAMP() do { if (STAMP && wid == 0 && nts < 64) { const unsigned long long _c = (unsigned long long)clock64(); \
        ts_lo = (lane == nts) ? (int)(unsigned)_c : ts_lo; ts_hi = (lane == nts) ? (int)(unsigned)(_c >> 32) : ts_hi; ++nts; } } while (0)
    PG8_STAMP();
    unsigned voffA[2], voffB[2];
#pragma unroll
    for (int i = 0; i < 2; ++i) { int R, C; stage_rc(tid * 16 + i * 8192, R, C); const int Rb = Epi::PERM ? ((R & ~31) + perm32(R & 31)) : R;
        voffA[i] = (unsigned)(R * K + C) * 2u; voffB[i] = (unsigned)(Rb * K + C) * 2u; }
    const size_t kstep = (size_t)(BK * 2);
    const size_t hstep = (size_t)HALF * K * 2;
    const size_t tstep = 2 * hstep;
    const unsigned ldsw = (unsigned)wid * 1024u;
    const int aoff = lds_byte(wr * 64 + fr, fq * 8), boff = lds_byte(wc * 32 + fr, fq * 8);
#define PG8_SA(b, h) (((b) * 2 + (h)) * HTB)
#define PG8_SB(b, h) ((4 + (b) * 2 + (h)) * HTB)
#define PG8_STAGE(bufoff, gbase, voff) do { _Pragma("unroll") for (int _i = 0; _i < 2; ++_i) \
        __builtin_amdgcn_global_load_lds((const unsigned*)((const char*)(gbase) + (voff)[_i]), (PG8_LAS unsigned*)(lds + (bufoff) + ldsw + _i * 8192), 16, 0, 0); } while (0)
#define PG8_LDA(dst, b, h) do { _Pragma("unroll") for (int m = 0; m < 4; ++m) _Pragma("unroll") for (int k = 0; k < 2; ++k) dst[m][k] = *(const PG8_LAS bf16x8*)(lds + PG8_SA(b, h) + aoff + m * 2048 + k * 1024); } while (0)
#define PG8_LDB(dst, b, h) do { _Pragma("unroll") for (int n = 0; n < 2; ++n) _Pragma("unroll") for (int k = 0; k < 2; ++k) dst[n][k] = *(const PG8_LAS bf16x8*)(lds + PG8_SB(b, h) + boff + n * 2048 + k * 1024); } while (0)
#define PG8_MMA(ai, bj, At, Bt) do { __builtin_amdgcn_s_setprio(1); _Pragma("unroll") for (int m = 0; m < 4; ++m) _Pragma("unroll") for (int n = 0; n < 2; ++n) _Pragma("unroll") for (int k = 0; k < 2; ++k) \
        acc[ai][bj][m][n] = __builtin_amdgcn_mfma_f32_16x16x32_bf16(Bt[n][k], At[m][k], acc[ai][bj][m][n], 0, 0, 0); __builtin_amdgcn_s_setprio(0); } while (0)
#define PG8_WAIT_V(n) asm volatile("s_waitcnt vmcnt(" #n ")" ::: "memory")
#define PG8_WAIT_L(n) asm volatile("s_waitcnt lgkmcnt(" #n ")" ::: "memory")
#define PG8_BAR __builtin_amdgcn_s_barrier()
#define PG8_SCHED __builtin_amdgcn_sched_barrier(0)
    Unit cur, nxt; int ui = 0;
    if (!S.next(0, cur)) return;
    f32x4 acc[2][2][4][2];
#pragma unroll
    for (int a = 0; a < 2; ++a)
#pragma unroll
        for (int b = 0; b < 2; ++b)
#pragma unroll
            for (int m = 0; m < 4; ++m)
#pragma unroll
                for (int n = 0; n < 2; ++n) acc[a][b][m][n] = (f32x4){0.f, 0.f, 0.f, 0.f};
    bf16x8 At[4][2], B0[2][2], B1[2][2];
    const char* cA = (const char*)g.A + (size_t)cur.pm * tstep; const char* cB = (const char*)g.Bt + (size_t)cur.pn * tstep;
    S.a_ready(cur);
    PG8_STAGE(PG8_SB(0, 0), cB, voffB); PG8_STAGE(PG8_SA(0, 0), cA, voffA); PG8_STAGE(PG8_SB(0, 1), cB + hstep, voffB); PG8_STAGE(PG8_SA(0, 1), cA + hstep, voffA);
    if (wr == 1) PG8_BAR;
    PG8_WAIT_V(4); PG8_BAR;
    PG8_STAGE(PG8_SB(1, 0), cB + kstep, voffB); PG8_STAGE(PG8_SA(1, 0), cA + kstep, voffA); PG8_STAGE(PG8_SB(1, 1), cB + hstep + kstep, voffB);
    PG8_WAIT_V(6); PG8_BAR;
    PG8_STAMP();
    for (;;) {
        const bool has_next = S.next(ui + 1, nxt);
        const char* nA = has_next ? (const char*)g.A + (size_t)nxt.pm * tstep : cA; const char* nB = has_next ? (const char*)g.Bt + (size_t)nxt.pn * tstep : cB;
        for (int t = 0; t < nt; t += 2) {
            const bool last = (t == nt - 2);
            const char* a1 = cA + (size_t)(t + 1) * kstep;
            const char* a2 = last ? nA : cA + (size_t)(t + 2) * kstep; const char* b2 = last ? nB : cB + (size_t)(t + 2) * kstep;
            const char* a3 = a2 + kstep; const char* b3 = b2 + kstep;
            if (last && has_next) S.a_ready(nxt);
            PG8_LDB(B0, 0, 0); PG8_SCHED; PG8_LDA(At, 0, 0); PG8_STAGE(PG8_SA(1, 1), a1 + hstep, voffA);
            PG8_WAIT_L(8); PG8_BAR; PG8_WAIT_L(0); PG8_MMA(0, 0, At, B0); PG8_BAR; PG8_SCHED;
            PG8_LDB(B1, 0, 1); PG8_STAGE(PG8_SB(0, 0), b2, voffB);
            PG8_BAR; PG8_WAIT_L(0); PG8_MMA(0, 1, At, B1); PG8_BAR;
            PG8_LDA(At, 0, 1); PG8_STAGE(PG8_SA(0, 0), a2, voffA);
            PG8_BAR; PG8_WAIT_L(0); PG8_MMA(1, 0, At, B0); PG8_BAR; PG8_SCHED;
            PG8_STAGE(PG8_SB(0, 1), b2 + hstep, voffB);
            PG8_WAIT_V(6); PG8_BAR; PG8_MMA(1, 1, At, B1); PG8_BAR;
            PG8_LDB(B0, 1, 0); PG8_SCHED; PG8_LDA(At, 1, 0); PG8_STAGE(PG8_SA(0, 1), a2 + hstep, voffA);
            PG8_WAIT_L(8); PG8_BAR; PG8_WAIT_L(0); PG8_MMA(0, 0, At, B0); PG8_BAR; PG8_SCHED;
            PG8_LDB(B1, 1, 1); PG8_STAGE(PG8_SB(1, 0), b3, voffB);
            PG8_BAR; PG8_WAIT_L(0); PG8_MMA(0, 1, At, B1); PG8_BAR;
            PG8_LDA(At, 1, 1); PG8_STAGE(PG8_SA(1, 0), a3, voffA);
            PG8_BAR; PG8_WAIT_L(0); PG8_MMA(1, 0, At, B0); PG8_BAR; PG8_SCHED;
            PG8_STAGE(PG8_SB(1, 1), b3 + hstep, voffB);
            PG8_WAIT_V(6); PG8_BAR; PG8_MMA(1, 1, At, B1); PG8_BAR;
        }
        PG8_STAMP();
        if constexpr (!Epi::AFTER_DRAIN) { E(acc, cur, wr, wc, fr, fq); S.done(cur); }
        PG8_STAMP();
        if (!has_next) break;
#pragma unroll
        for (int a = 0; a < 2; ++a)
#pragma unroll
            for (int b = 0; b < 2; ++b)
#pragma unroll
                for (int m = 0; m < 4; ++m)
#pragma unroll
                    for (int n = 0; n < 2; ++n) acc[a][b][m][n] = (f32x4){0.f, 0.f, 0.f, 0.f};
        cur = nxt; cA = nA; cB = nB; ++ui;
    }
    PG8_WAIT_V(0);
    if (wr == 0) PG8_BAR;
    PG8_BAR;
    if constexpr (Epi::AFTER_DRAIN) { E.fused(acc, cur, wr, wc, fr, fq, lds, wid, lane); S.done(cur); }
    PG8_STAMP();
    if (STAMP && wid == 0) { stamps[lane] = lane < nts ? (((unsigned long long)(unsigned)ts_hi << 32) | (unsigned)ts_lo) : 0ull;
        if (lane == 62) stamps[62] = rt_entry; if (lane == 63) stamps[63] = (unsigned long long)wall_clock64(); }
#undef PG8_STAMP
#undef PG8_SA
#undef PG8_SB
#undef PG8_STAGE
#undef PG8_LDA
#undef PG8_LDB
#undef PG8_MMA
#undef PG8_WAIT_V
#undef PG8_WAIT_L
#undef PG8_BAR
#undef PG8_SCHED
}
}

struct Epi1 {
  static constexpr bool PERM = true, AFTER_DRAIN = false;
  bf16_t* P;
  DI void operator()(const f32x4 (&acc)[2][2][4][2], const pg8::Unit& u, int wr, int wc, int fr, int fq) const {
    const int row0 = u.pm * 256 + wr * 64 + fr;
#pragma unroll
    for (int bj = 0; bj < 2; ++bj) { const int hidx = u.pn * 2 + bj;
      const bool sl = (hidx >= 12 && hidx < 20) || (hidx >= 32 && hidx < 36) || (hidx >= 48 && hidx < 52);
#pragma unroll
      for (int ai = 0; ai < 2; ++ai)
#pragma unroll
        for (int m = 0; m < 4; ++m) { f32x4 v0 = acc[ai][bj][m][0], v1 = acc[ai][bj][m][1];
          if (sl) { for (int e = 0; e < 4; ++e) { v0[e] = silu_f(v0[e]); v1[e] = silu_f(v1[e]); } }
          u32x4 w = {pk2(v0[0], v0[1]), pk2(v0[2], v0[3]), pk2(v1[0], v1[1]), pk2(v1[2], v1[3])};
          *(u32x4*)(P + pidx(hidx, row0 + ai * 128 + m * 16) + wc * 32 + 8 * fq) = w; } }
  }
};
struct Epi2 {
  static constexpr bool PERM = true, AFTER_DRAIN = false;
  const float* MOD; bf16_t* Y;
  DI void operator()(const f32x4 (&acc)[2][2][4][2], const pg8::Unit& u, int wr, int wc, int fr, int fq) const {
    const int b = u.pm / 17; const bool isctx = (u.pm % 17) == 0;
    const int row0 = u.pm * 256 + wr * 64 + fr, col0 = u.pn * 256 + wc * 32 + 8 * fq;
    const float* gate = MOD + (isctx ? 4 : b) * 6144 + 4096 + col0;
    f32x4 gv[2][2];
#pragma unroll
    for (int bj = 0; bj < 2; ++bj)
#pragma unroll
      for (int n = 0; n < 2; ++n) gv[bj][n] = *(const f32x4*)(gate + bj * 128 + 4 * n);
#pragma unroll
    for (int ai = 0; ai < 2; ++ai)
#pragma unroll
      for (int m = 0; m < 4; ++m) { bf16_t* rowp = Y + (size_t)(row0 + ai * 128 + m * 16) * DM + col0;
#pragma unroll
        for (int bj = 0; bj < 2; ++bj) { const f32x4 v0 = acc[ai][bj][m][0] * gv[bj][0], v1 = acc[ai][bj][m][1] * gv[bj][1];
          u32x4 w = {pk2(v0[0], v0[1]), pk2(v0[2], v0[3]), pk2(v1[0], v1[1]), pk2(v1[2], v1[3])};
          *(u32x4*)(rowp + bj * 128) = w; } }
  }
};
struct LatentOrder : pg8::StaticOrder {
  __device__ bool next(int i, pg8::Unit& u) const { if (!pg8::StaticOrder::next(i, u)) return false; u.pm = (u.pm >> 4) * 17 + 1 + (u.pm & 15); return true; }
};
DI void phase_gemm1(const Params& p, int layer) {
  pg8::Gemm g{(const bf16_t*)(p.ws + WS_HC), (const bf16_t*)(p.ws + WS_WINT), MTOK, NPW, DM};
  pg8::StaticOrder S; S.init(MTOK, NPW, gridDim.x, blockIdx.x);
  Epi1 E{(bf16_t*)(p.ws + WS_P)};
  pg8::gemm_phase<Epi1, pg8::StaticOrder, false>((PG8_LAS unsigned char*)smem, g, S, E, nullptr);
}
DI void phase_gates(const Params& p) {
  const int tid = opaque_tid(), wid = __builtin_amdgcn_readfirstlane(tid >> 6), lane = tid & 63, fr = lane & 15, fq = lane >> 4;
  const bf16_t* H = (const bf16_t*)(p.ws + WS_HC); const bf16_t* WG = (const bf16_t*)(p.ws + WS_WG); float* GT = (float*)(p.ws + WS_GT);
  f32x4* red = (f32x4*)smem;
  for (int rb = blockIdx.x; rb < MTOK / 64; rb += gridDim.x) {
    __syncthreads();
    f32x4 acc[4];
#pragma unroll
    for (int m = 0; m < 4; ++m) acc[m] = (f32x4){0.f, 0.f, 0.f, 0.f};
#pragma unroll
    for (int ks = 0; ks < 8; ++ks) { const int k0 = wid * 256 + ks * 32 + fq * 8;
      const bf16x8 bw = *(const bf16x8*)(WG + fr * DM + k0);
#pragma unroll
      for (int m = 0; m < 4; ++m) { const bf16x8 a = *(const bf16x8*)(H + (size_t)(rb * 64 + m * 16 + fr) * DM + k0);
        acc[m] = __builtin_amdgcn_mfma_f32_16x16x32_bf16(a, bw, acc[m], 0, 0, 0); } }
#pragma unroll
    for (int m = 0; m < 4; ++m) red[(wid * 4 + m) * 64 + lane] = acc[m];
    __syncthreads();
    if (tid < 256) { const int m = tid >> 6, ln = tid & 63; f32x4 sacc = red[m * 64 + ln];
#pragma unroll
      for (int w = 1; w < 8; ++w) sacc += red[(w * 4 + m) * 64 + ln];
      float* g = GT + (size_t)(rb * 64 + m * 16 + (ln >> 4) * 4) * 16 + (ln & 15);
      g[0] = sacc[0]; g[16] = sacc[1]; g[32] = sacc[2]; g[48] = sacc[3]; }
  }
}
DI void phase_gemm2(const Params& p, int layer) {
  pg8::Gemm g{(const bf16_t*)(p.ws + WS_HC), (const bf16_t*)(p.ws + WS_WOUT), MTOK, DM, DM};
  Epi2 E{(const float*)(p.ws + WS_MOD) + layer * 5 * 6144, (bf16_t*)(p.ws + WS_P)};
  if (layer == 0) { pg8::StaticOrder S; S.init(MTOK, DM, gridDim.x, blockIdx.x); pg8::gemm_phase<Epi2, pg8::StaticOrder, false>((PG8_LAS unsigned char*)smem, g, S, E, nullptr); }
  else { LatentOrder S; S.init(64 * 256, DM, gridDim.x, blockIdx.x); pg8::gemm_phase<Epi2, LatentOrder, false>((PG8_LAS unsigned char*)smem, g, S, E, nullptr); }
}

DI void phase_qknorm(const Params& p, int layer) {
  bf16_t* P = (bf16_t*)(p.ws + WS_P);
  const int l16 = threadIdx.x & 15, d8 = l16 * 8, stride = gridDim.x * 32;
  float invf[8];
#pragma unroll
  for (int e = 0; e < 8; ++e) invf[e] = exp2f(-(float)((d8 & 31) + e) * (13.287712379549449f / 32.f));
  for (int it0 = blockIdx.x * 32 + (threadIdx.x >> 4); it0 < MTOK * 10; it0 += stride * 4) {
    bf16x8 xin[4];
#pragma unroll
    for (int k = 0; k < 4; ++k) { const int it = it0 + k * stride; xin[k] = (bf16x8){0, 0, 0, 0, 0, 0, 0, 0};
      if (it < MTOK * 10) xin[k] = *(const bf16x8*)(P + pidx(it % 10, it / 10) + d8); }
#pragma unroll
    for (int k = 0; k < 4; ++k) { const int it = it0 + k * stride; const bool live = it < MTOK * 10;
      const int row = it / 10, hd = it % 10;
      float y[8]; float ss = 0.f;
#pragma unroll
      for (int e = 0; e < 8; ++e) { y[e] = bf2f((bf16_t)xin[k][e]); ss += y[e] * y[e]; }
      ss += __shfl_xor(ss, 1); ss += __shfl_xor(ss, 2); ss += __shfl_xor(ss, 4); ss += __shfl_xor(ss, 8);
      const float rs = rsqrtf(ss * (1.f / 128.f) + EPS);
      const float* gw = (hd < 8 ? p.q_norm : p.k_norm) + layer * HD + d8;
#pragma unroll
      for (int e = 0; e < 8; ++e) y[e] = y[e] * rs * gw[e];
      const int tin = row % TPB;
      float other[8];
#pragma unroll
      for (int e = 0; e < 8; ++e) other[e] = __shfl_xor(y[e], 4);
      if (tin >= CTX) { const int sq = tin - CTX; const float pos = (float)((d8 >> 6) == 0 ? (sq >> 6) : (sq & 63)); const bool part1 = (d8 >> 5) & 1;
#pragma unroll
        for (int e = 0; e < 8; ++e) { float sn, cs; __sincosf(pos * invf[e], &sn, &cs);
          y[e] = part1 ? (y[e] * cs + other[e] * sn) : (y[e] * cs - other[e] * sn); } }
      if (live) { u32x4 w = {pk2(y[0], y[1]), pk2(y[2], y[3]), pk2(y[4], y[5]), pk2(y[6], y[7])};
        *(u32x4*)(P + pidx(hd, row) + d8) = w; } }
  }
}

constexpr int KVBLK = 64;
constexpr float SCALE = 0.088388347648318440f;
constexpr float THR = 8.f;
constexpr size_t SHM_V = KVBLK * HD * 2, SHM_K = KVBLK * HD * 2;
#define KSWZ(row, colB) ((row) * 256 + ((colB) ^ (((row) & 7) << 4)))
#define SBAR() __builtin_amdgcn_sched_barrier(0)
DI unsigned cvtpk(float lo, float hi) { unsigned r; asm volatile("v_cvt_pk_bf16_f32 %0, %1, %2" : "=v"(r) : "v"(lo), "v"(hi)); return r; }

DI void partialSM(f32x16& p0, f32x16& p1, float& m_reg, float& mn, float& alpha) {
  constexpr float C = SCALE * 1.4426950408889634f;
  float pmax = p0[0];
#pragma unroll
  for (int r = 1; r < 16; ++r) pmax = fmaxf(pmax, p0[r]);
#pragma unroll
  for (int r = 0; r < 16; ++r) pmax = fmaxf(pmax, p1[r]);
  { auto rr = __builtin_amdgcn_permlane32_swap(__float_as_uint(pmax), __float_as_uint(pmax), false, false);
    pmax = fmaxf(__uint_as_float(rr[0]), __uint_as_float(rr[1])); }
  if (__builtin_expect(__all(pmax - m_reg <= THR / SCALE), 1)) { mn = m_reg; alpha = 1.f; }
  else { mn = fmaxf(m_reg, pmax); alpha = __builtin_amdgcn_exp2f((m_reg - mn) * C); m_reg = mn; }
  float mnC = -mn * C;
#pragma unroll
  for (int r = 0; r < 16; ++r) p0[r] = fmaf(p0[r], C, mnC);
#pragma unroll
  for (int r = 0; r < 16; ++r) p1[r] = fmaf(p1[r], C, mnC);
#pragma unroll
  for (int r = 0; r < 16; ++r) p0[r] = __builtin_amdgcn_exp2f(p0[r]);
}
DI void finishSM(f32x16& p0, f32x16& p1, float alpha, float& l_reg, bf16x8& pa0, bf16x8& pa1, bf16x8& pa2, bf16x8& pa3) {
#pragma unroll
  for (int r = 0; r < 16; ++r) p1[r] = __builtin_amdgcn_exp2f(p1[r]);
  float ps = 0;
#pragma unroll
  for (int r = 0; r < 16; ++r) ps += p0[r];
#pragma unroll
  for (int r = 0; r < 16; ++r) ps += p1[r];
  { auto rr = __builtin_amdgcn_permlane32_swap(__float_as_uint(ps), __float_as_uint(ps), false, false);
    ps = __uint_as_float(rr[0]) + __uint_as_float(rr[1]); }
  l_reg = l_reg * alpha + ps;
#define PK4(P, BASE, OUT) do { unsigned a0 = cvtpk(P[BASE + 0], P[BASE + 1]), a1 = cvtpk(P[BASE + 2], P[BASE + 3]);   \
    unsigned b0 = cvtpk(P[BASE + 4], P[BASE + 5]), b1 = cvtpk(P[BASE + 6], P[BASE + 7]);                              \
    auto r0 = __builtin_amdgcn_permlane32_swap(a0, b0, false, false); auto r1 = __builtin_amdgcn_permlane32_swap(a1, b1, false, false); \
    u32x4 w = {r0[0], r1[0], r0[1], r1[1]}; OUT = *reinterpret_cast<bf16x8*>(&w); } while (0)
  PK4(p0, 0, pa0); PK4(p0, 8, pa1); PK4(p1, 0, pa2); PK4(p1, 8, pa3);
#undef PK4
}
DI void qkt(f32x16& p0, f32x16& p1, const char* Ks, const bf16x8* qr, int r32, int hi) {
  p0 = f32x16{}; p1 = f32x16{};
#pragma unroll
  for (int d0 = 0; d0 < 8; ++d0) { int cb = (d0 * 16 + hi * 8) * 2;
    bf16x8 b0 = *reinterpret_cast<const bf16x8*>(Ks + KSWZ(r32, cb));
    bf16x8 b1 = *reinterpret_cast<const bf16x8*>(Ks + KSWZ(32 + r32, cb));
    p0 = __builtin_amdgcn_mfma_f32_32x32x16_bf16(b0, qr[d0], p0, 0, 0, 0);
    p1 = __builtin_amdgcn_mfma_f32_32x32x16_bf16(b1, qr[d0], p1, 0, 0, 0); }
}
DI int v_st(int k, int c) { const int kk = (k & ~0xC) | ((k & 4) << 1) | ((k & 8) >> 1); return ((kk >> 3) * 4 + (c >> 5)) * 512 + ((kk & 7) * 32 + (c & 31)) * 2; }
DI int v_rd_base(int lane) { return ((lane & 3) << 3) | (((lane >> 2) & 3) << 6) | (((lane >> 4) & 1) << 5) | (((lane >> 5) & 1) << 8); }
constexpr int v_rd_off(int d0, int ks, int half) { return d0 * 512 + ks * 4096 + half * 2048; }
template <int OFF> DI s16x4 tr_read(int vb) {
  s16x4 r; asm volatile("ds_read_b64_tr_b16 %0, %1 offset:%2" : "=&v"(r) : "v"(vb), "i"(OFF) : "memory"); return r;
}
template <int D0> DI void pv_one(f32x16& od, int vb, bf16x8 pa0, bf16x8 pa1, bf16x8 pa2, bf16x8 pa3) {
  const s16x4 l0 = tr_read<v_rd_off(D0, 0, 0)>(vb), h0 = tr_read<v_rd_off(D0, 0, 1)>(vb), l1 = tr_read<v_rd_off(D0, 1, 0)>(vb), h1 = tr_read<v_rd_off(D0, 1, 1)>(vb);
  const s16x4 l2 = tr_read<v_rd_off(D0, 2, 0)>(vb), h2 = tr_read<v_rd_off(D0, 2, 1)>(vb), l3 = tr_read<v_rd_off(D0, 3, 0)>(vb), h3 = tr_read<v_rd_off(D0, 3, 1)>(vb);
  asm volatile("s_waitcnt lgkmcnt(0)" ::: "memory"); SBAR();
#define PKV(L, H) (bf16x8){L[0], L[1], L[2], L[3], H[0], H[1], H[2], H[3]}
  od = __builtin_amdgcn_mfma_f32_32x32x16_bf16(pa0, PKV(l0, h0), od, 0, 0, 0);
  od = __builtin_amdgcn_mfma_f32_32x32x16_bf16(pa1, PKV(l1, h1), od, 0, 0, 0);
  od = __builtin_amdgcn_mfma_f32_32x32x16_bf16(pa2, PKV(l2, h2), od, 0, 0, 0);
  od = __builtin_amdgcn_mfma_f32_32x32x16_bf16(pa3, PKV(l3, h3), od, 0, 0, 0);
#undef PKV
}
DI void pv_d0(f32x16* o, int vb, bf16x8 pa0, bf16x8 pa1, bf16x8 pa2, bf16x8 pa3) {
  pv_one<0>(o[0], vb, pa0, pa1, pa2, pa3); pv_one<1>(o[1], vb, pa0, pa1, pa2, pa3); pv_one<2>(o[2], vb, pa0, pa1, pa2, pa3); pv_one<3>(o[3], vb, pa0, pa1, pa2, pa3);
}

DI void na_apply(f32x16& p0, f32x16& p1, int rk, int rq, int cq, const float* rpb_h, int hi) {
  const int r0 = min(max(rq - 4, 0), 56), c0 = min(max(cq - 8, 0), 48);
  const bool rowok = rk >= r0 && rk < r0 + 8;
  const float* bp = rpb_h + (rk - rq + 7) * 31 + 15 - cq;
#pragma unroll
  for (int r = 0; r < 16; ++r) { const int ck = crow(r, hi); const bool ok = rowok && ck >= c0 && ck < c0 + 16;
    float bias = 0.f; if (ok) bias = bp[ck]; p0[r] = ok ? p0[r] + bias * (1.f / SCALE) : -1e30f; }
#pragma unroll
  for (int r = 0; r < 16; ++r) { const int ck = 32 + crow(r, hi); const bool ok = rowok && ck >= c0 && ck < c0 + 16;
    float bias = 0.f; if (ok) bias = bp[ck]; p1[r] = ok ? p1[r] + bias * (1.f / SCALE) : -1e30f; }
}

template <bool NA, int SD>
DI void attn_body(const bf16_t* __restrict__ Qb, const bf16_t* __restrict__ Kb, const bf16_t* __restrict__ Vb, const bf16_t* __restrict__ Zb,
                  bf16_t* __restrict__ Ob, int NT, int rlo, int rq0, const float* rpb_h, float oscale = 1.f) {
  char* lds = smem;
  const int tid = opaque_tid(), wid = __builtin_amdgcn_readfirstlane(tid >> 6), lane = tid & 63, r32 = lane & 31, hi = lane >> 5;
  char* V_lds = lds; char* K_lds = lds + 2 * SHM_V;
  float* wsx = (float*)(lds + 2 * SHM_V + 2 * SHM_K) + wid * 64; float* li_l = wsx; float* al_l = wsx + 32;
  const int toff = NA ? 0 : rq0;
  float m_reg = -1e30f, l_reg = 0; f32x16 o[4] = {}; bf16x8 qr[8];
  const bf16_t* Qw = Qb + (size_t)(wid * 32 + r32) * HD + hi * 8;
#pragma unroll
  for (int d0 = 0; d0 < 8; ++d0) qr[d0] = *(const bf16x8*)(Qw + d0 * 16);
  const int sr = tid >> 4, sc = (tid & 15) * 8, vst0 = v_st(sr, sc), vst1 = v_st(32 + sr, sc);
  const int vb0 = (int)(uintptr_t)V_lds + v_rd_base(lane);
  const int rq = rq0 + (wid >> 1), cq = (wid & 1) * 32 + r32;
  struct { bf16x8 vs0, vs1, ks0, ks1; } sr_[SD];
#define TROW(j) (NA ? ((j) < 4 ? (j) * 64 : CTX + (rlo + (j) - 4) * 64) : (((j) + toff) % NT) * 64)
#define SLOAD(i, j) do { const size_t k0_ = (size_t)TROW(j); sr_[i].vs0 = *(const bf16x8*)(&Vb[(k0_ + sr) * HD + sc]); sr_[i].vs1 = *(const bf16x8*)(&Vb[(k0_ + 32 + sr) * HD + sc]); \
    sr_[i].ks0 = *(const bf16x8*)(&Kb[(k0_ + sr) * HD + sc]); sr_[i].ks1 = *(const bf16x8*)(&Kb[(k0_ + 32 + sr) * HD + sc]); } while (0)
#define SWRITE(b, i) do { *(bf16x8*)(V_lds + (b) * SHM_V + vst0) = sr_[i].vs0;          \
    *(bf16x8*)(V_lds + (b) * SHM_V + vst1) = sr_[i].vs1; int kc = sc * 2;               \
    *(bf16x8*)(K_lds + (b) * SHM_K + KSWZ(sr, kc)) = sr_[i].ks0;                       \
    *(bf16x8*)(K_lds + (b) * SHM_K + KSWZ(32 + sr, kc)) = sr_[i].ks1; } while (0)
#define SWAIT() do { if constexpr (SD == 2) asm volatile("s_waitcnt vmcnt(4)" ::: "memory"); else asm volatile("s_waitcnt vmcnt(0)" ::: "memory"); } while (0)
#define RESC(a) do { if (__any((a) < 1.f)) { if (hi == 0) al_l[r32] = (a); asm volatile("s_waitcnt lgkmcnt(0)" ::: "memory"); \
    for (int d = 0; d < 4; ++d) for (int r = 0; r < 16; ++r) o[d][r] *= al_l[crow(r, hi)]; } } while (0)
#define NAMASK(PA, PB, j) do { if (NA && (j) >= 4) na_apply(PA, PB, rlo + (j) - 4, rq, cq, rpb_h, hi); } while (0)
  f32x16 pA0, pA1, pB0, pB1; float mnA, mnB, alA, alB; bf16x8 pa0, pa1, pa2, pa3;
  constexpr int SE = 0, SO = SD - 1;
  SLOAD(SE, 0); asm volatile("s_waitcnt vmcnt(0)" ::: "memory"); SWRITE(0, SE); __syncthreads();
  qkt(pA0, pA1, K_lds, qr, r32, hi); NAMASK(pA0, pA1, 0); partialSM(pA0, pA1, m_reg, mnA, alA);
  SLOAD(SO, 1); if constexpr (SD == 2) { if (2 < NT) SLOAD(SE, 2); }
  SWAIT(); SWRITE(1, SO); __syncthreads();
  for (int j = 1; j + 1 < NT; j += 2) {
    SBAR(); qkt(pB0, pB1, K_lds + SHM_K, qr, r32, hi); NAMASK(pB0, pB1, j);
    finishSM(pA0, pA1, alA, l_reg, pa0, pa1, pa2, pa3); SBAR();
    SLOAD(SO, j + SD); SBAR();
    pv_d0(o, vb0, pa0, pa1, pa2, pa3); partialSM(pB0, pB1, m_reg, mnB, alB);
    __syncthreads(); SWAIT(); SWRITE(0, SE);
    RESC(alB); __syncthreads();
    SBAR(); qkt(pA0, pA1, K_lds, qr, r32, hi); NAMASK(pA0, pA1, j + 1);
    finishSM(pB0, pB1, alB, l_reg, pa0, pa1, pa2, pa3); SBAR();
    if (SD == 1 || j + 3 < NT) SLOAD(SE, j + 1 + SD); SBAR();
    pv_d0(o, vb0 + (int)SHM_V, pa0, pa1, pa2, pa3); partialSM(pA0, pA1, m_reg, mnA, alA);
    __syncthreads(); SWAIT(); SWRITE(1, SO);
    RESC(alA); __syncthreads();
  }
  SBAR(); qkt(pB0, pB1, K_lds + SHM_K, qr, r32, hi); NAMASK(pB0, pB1, NT - 1);
  finishSM(pA0, pA1, alA, l_reg, pa0, pa1, pa2, pa3); SBAR();
  pv_d0(o, vb0, pa0, pa1, pa2, pa3); partialSM(pB0, pB1, m_reg, mnB, alB);
  __syncthreads(); RESC(alB);
  finishSM(pB0, pB1, alB, l_reg, pa0, pa1, pa2, pa3); SBAR();
  pv_d0(o, vb0 + (int)SHM_V, pa0, pa1, pa2, pa3);
  if (hi == 0) li_l[r32] = l_reg; asm volatile("s_waitcnt lgkmcnt(0)" ::: "memory");
  float rli[16];
#pragma unroll
  for (int r = 0; r < 16; ++r) rli[r] = __builtin_amdgcn_rcpf(li_l[crow(r, hi)]);
  bf16_t* Ow = Ob + (size_t)(wid * 32) * DM; const bf16_t* Zw = Zb + (size_t)(wid * 32) * HD;
#pragma unroll
  for (int r = 0; r < 16; ++r) { const int orow = crow(r, hi);
#pragma unroll
    for (int d0 = 0; d0 < 4; ++d0) { const float gz = bf2f(Zw[(size_t)orow * HD + d0 * 32 + r32]);
      Ow[(size_t)orow * DM + d0 * 32 + r32] = f2bf(o[d0][r] * rli[r] * gz * oscale); } }
#undef SLOAD
#undef SWRITE
#undef SWAIT
#undef RESC
#undef NAMASK
#undef TROW
}

constexpr int PL_QS = 0, PL_KS = 17408, PL_VT = 34816, PL_KTT = 53248, PL_LM = 71680, PL_TU = 106496, PL_TW = 124928, PL_G = 143360;
DI void dn_prep(const Params& p, int layer, int task) {
  const int tid = opaque_tid(), wid = tid >> 6, lane = tid & 63, fr = lane & 15, fq = lane >> 4;
  const int bh = task / NCH, ch = task % NCH, b = bh >> 2, h = bh & 3;
  const size_t tok0 = (size_t)b * TPB + ch * 64;
  const bool has_left = !(ch == 0 || ch == 4), has_right = !(ch == 3 || ch == NCH - 1);
  const bf16_t* P = (const bf16_t*)(p.ws + WS_P); const float* GT = (const float*)(p.ws + WS_GT);
  bf16_t* qs = (bf16_t*)(smem + PL_QS); bf16_t* ks = (bf16_t*)(smem + PL_KS); bf16_t* vT = (bf16_t*)(smem + PL_VT); bf16_t* kT = (bf16_t*)(smem + PL_KTT);
  float* Lm = (float*)(smem + PL_LM); bf16_t* Tu = (bf16_t*)(smem + PL_TU); bf16_t* Tw = (bf16_t*)(smem + PL_TW);
  float* gbeta = (float*)(smem + PL_G); float* ggc = gbeta + 128; float* geg = gbeta + 256;
  bf16_t* QN = (bf16_t*)(p.ws + WS_QN) + (size_t)(bh * NCH + ch) * 64 * 128;
  bf16_t* KTg = (bf16_t*)(p.ws + WS_KT) + (size_t)(bh * NCH + ch) * 128 * 64;

  float* ssbuf = (float*)(smem + 144896);
  if (tid < 128) ssbuf[tid] = 0.f;
  __syncthreads();
  if (wid < 2) { const int dir = wid;
    const float* gr = GT + (tok0 + lane) * 16 + dir * 8;
    const float beta = 1.f / (1.f + __expf(-gr[h]));
    const float a = gr[4 + h] + p.dt_bias[layer * 8 + dir * 4 + h];
    const float sp = a > 20.f ? a : log1pf(__expf(a));
    float x = -__expf(p.a_log[layer * 8 + dir * 4 + h]) * sp;
    if (dir == 0) { for (int o = 1; o < 64; o <<= 1) { float t = __shfl_up(x, o); if (lane >= o) x += t; } }
    else { for (int o = 1; o < 64; o <<= 1) { float t = __shfl_down(x, o); if (lane + o < 64) x += t; } }
    const float glast = __shfl(x, dir == 0 ? 63 : 0);
    const float eg = __expf(x);
    gbeta[dir * 64 + lane] = beta; ggc[dir * 64 + lane] = x; geg[dir * 64 + lane] = eg;
    float* GC = (float*)(p.ws + WS_GC) + (size_t)((bh * 2 + dir) * NCH + ch) * 136;
    GC[lane] = eg; GC[64 + lane] = __expf(glast - x); if (lane == 0) GC[128] = __expf(glast);
  }
  SBAR();
  bf16_t* raw = (bf16_t*)(smem + PL_LM);
  { bf16x8 rv[7];
#pragma unroll
    for (int i = 0; i < 7; ++i) { const int idx = tid + i * 512, rr = idx >> 4, ck = idx & 15, which = rr / 66, lr = rr % 66;
      rv[i] = (bf16x8){0, 0, 0, 0, 0, 0, 0, 0};
      if (idx < 3 * 66 * 16 && (lr > 0 || has_left) && (lr < 65 || has_right)) rv[i] = *(const bf16x8*)(P + pidx(36 + which * 4 + h, tok0 + lr - 1) + ck * 8); }
#pragma unroll
    for (int i = 0; i < 7; ++i) { const int idx = tid + i * 512, rr = idx >> 4, ck = idx & 15;
      if (idx < 3 * 66 * 16) *(bf16x8*)(raw + rr * 136 + ck * 8) = rv[i]; } }
  __syncthreads();
  float yv[6][8];
  const int wu = __builtin_amdgcn_readfirstlane(wid);
  { const int c = lane;
#pragma unroll
    for (int k = 0; k < 6; ++k) { const int chk = wu * 6 + k, which = chk >> 4, d8 = (chk & 15) * 8;
      const bf16_t* rp = raw + (which * 66 + c) * 136 + d8;
      const bf16x8 xm = *(const bf16x8*)rp, x0 = *(const bf16x8*)(rp + 136), xp = *(const bf16x8*)(rp + 272);
      const float* cw = p.conv_w + (size_t)layer * 3 * 1536 + which * 512 + h * 128 + d8;
      float ss = 0.f;
#pragma unroll
      for (int e = 0; e < 8; ++e) { float v = cw[e] * bf2f((bf16_t)xm[e]) + cw[1536 + e] * bf2f((bf16_t)x0[e]) + cw[3072 + e] * bf2f((bf16_t)xp[e]);
        v = silu_f(v); yv[k][e] = v; ss += v * v; }
      if (which < 2) atomicAdd(&ssbuf[which * 64 + c], ss); } }
  __syncthreads();
  { const int c = lane, cp = perm_k(c);
#pragma unroll
    for (int k = 0; k < 6; ++k) { const int chk = wu * 6 + k, which = chk >> 4, d8 = (chk & 15) * 8;
      float rn = 1.f; if (which < 2) rn = rsqrtf(ssbuf[which * 64 + c] + EPS) * (which == 0 ? 0.088388347648318440f : 1.f);
      float y[8];
#pragma unroll
      for (int e = 0; e < 8; ++e) y[e] = yv[k][e] * rn;
      if (which == 0) { u32x4 w = {pk2(y[0], y[1]), pk2(y[2], y[3]), pk2(y[4], y[5]), pk2(y[6], y[7])};
        *(u32x4*)(qs + c * 136 + d8) = w;
        bf16_t* qd = QN + c * 128; const int c0 = (d8 >> 4) * 2, sw = c & 15, wi = (d8 & 8) ? 4 : 0;
        *(u32x2*)(qd + ((c0 ^ sw) << 3) + wi) = (u32x2){w.x, w.y}; *(u32x2*)(qd + (((c0 + 1) ^ sw) << 3) + wi) = (u32x2){w.z, w.w};
      } else if (which == 1) { u32x4 w = {pk2(y[0], y[1]), pk2(y[2], y[3]), pk2(y[4], y[5]), pk2(y[6], y[7])};
        *(u32x4*)(ks + c * 136 + d8) = w;
#pragma unroll
        for (int e = 0; e < 8; ++e) { const bf16_t kv = f2bf(y[e]); const int d = d8 + e; kT[d * 72 + c] = kv; KTg[d * 64 + ((((cp >> 3) ^ ((d >> 1) & 7)) << 3) | (cp & 7))] = kv; }
      } else {
#pragma unroll
        for (int e = 0; e < 8; ++e) vT[(d8 + e) * 72 + c] = f2bf(y[e]);
      } } }
  __syncthreads();
  SBAR();
  { const int sel = wid >> 2, mi = wid & 3;
    const bf16_t* Ar = (sel == 0 ? ks : qs) + (mi * 16 + fr) * 136 + fq * 8;
    f32x4 acc[4];
#pragma unroll
    for (int n = 0; n < 4; ++n) acc[n] = (f32x4){0.f, 0.f, 0.f, 0.f};
#pragma unroll
    for (int kk = 0; kk < 4; ++kk) { const bf16x8 a = *(const bf16x8*)(Ar + kk * 32);
#pragma unroll
      for (int n = 0; n < 4; ++n) { const bf16x8 bb = *(const bf16x8*)(ks + (n * 16 + fr) * 136 + kk * 32 + fq * 8);
        acc[n] = __builtin_amdgcn_mfma_f32_16x16x32_bf16(a, bb, acc[n], 0, 0, 0); } }
    bf16_t* QKg = (bf16_t*)(p.ws + WS_QK);
#pragma unroll
    for (int n = 0; n < 4; ++n)
#pragma unroll
      for (int j = 0; j < 4; ++j) { const int i = mi * 16 + fq * 4 + j, jj = n * 16 + fr; const float val = acc[n][j];
#pragma unroll
        for (int dir = 0; dir < 2; ++dir) { const float e = __expf(fminf(ggc[dir * 64 + i] - ggc[dir * 64 + jj], 0.f));
          if (sel == 0) { const bool ok = dir == 0 ? (i > jj) : (i < jj); const float lv = ok ? gbeta[dir * 64 + i] * val * e : 0.f;
            const int i2 = dir == 0 ? i : 63 - i, j2 = dir == 0 ? jj : 63 - jj; Lm[(dir * 64 + i2) * 68 + j2] = lv; }
          else { const bool ok = dir == 0 ? (i >= jj) : (i <= jj);
            const int pj = perm_k(jj);
            QKg[((size_t)((bh * 2 + dir) * NCH + ch) * 64 + i) * 64 + ((((pj >> 3) ^ ((i >> 1) & 7)) << 3) | (pj & 7))] = f2bf(ok ? val * e : 0.f); } } }
  }
  __syncthreads();
  SBAR();
  if (wid < 2) { const int dir = wid; const float* Lr = Lm + dir * 64 * 68;
    float t[64];
#pragma unroll
    for (int i = 0; i < 64; ++i) t[i] = 0.f;
#pragma unroll
    for (int i = 0; i < 64; ++i) { float a0 = (i == lane) ? 1.f : 0.f, a1 = 0.f, a2 = 0.f, a3 = 0.f;
#pragma unroll
      for (int j4 = 0; j4 < (i + 3) / 4; ++j4) { const f32x4 l = *(const f32x4*)(Lr + i * 68 + j4 * 4);
        a0 -= l[0] * t[j4 * 4]; a1 -= l[1] * t[j4 * 4 + 1]; a2 -= l[2] * t[j4 * 4 + 2]; a3 -= l[3] * t[j4 * 4 + 3]; }
      const float a = (a0 + a1) + (a2 + a3);
      t[i] = a; Lm[(dir * 64 + i) * 68 + lane] = a; }
  }
  __syncthreads();
  SBAR();
#pragma unroll 1
  for (int i = 0; i < 16; ++i) { const int idx = tid + i * 512, dir = idx >> 12, i2 = (idx >> 6) & 63, j2 = idx & 63;
    const float tv = Lm[(dir * 64 + i2) * 68 + j2];
    const int ir = dir == 0 ? i2 : 63 - i2, jc = dir == 0 ? j2 : 63 - j2;
    const float bj = gbeta[dir * 64 + jc];
    Tu[(dir * 64 + ir) * 72 + jc] = f2bf(tv * bj); Tw[(dir * 64 + ir) * 72 + jc] = f2bf(tv * bj * geg[dir * 64 + jc]); }
  __syncthreads();
  SBAR();
  { const int mat = wid >> 1, nh = wid & 1, dir = mat & 1, isw = mat >> 1;
    const bf16_t* Am = (isw ? Tw : Tu) + dir * 64 * 72; const bf16_t* Bm = isw ? kT : vT;
    f32x4 acc[4][4];
#pragma unroll
    for (int m = 0; m < 4; ++m)
#pragma unroll
      for (int n = 0; n < 4; ++n) acc[m][n] = (f32x4){0.f, 0.f, 0.f, 0.f};
#pragma unroll
    for (int kk = 0; kk < 2; ++kk) { bf16x8 a[4], bb[4];
#pragma unroll
      for (int m = 0; m < 4; ++m) a[m] = *(const bf16x8*)(Am + (m * 16 + fr) * 72 + kk * 32 + fq * 8);
#pragma unroll
      for (int n = 0; n < 4; ++n) bb[n] = *(const bf16x8*)(Bm + ((nh * 4 + n) * 16 + fr) * 72 + kk * 32 + fq * 8);
#pragma unroll
      for (int m = 0; m < 4; ++m)
#pragma unroll
        for (int n = 0; n < 4; ++n) acc[m][n] = __builtin_amdgcn_mfma_f32_16x16x32_bf16(a[m], bb[n], acc[m][n], 0, 0, 0); }
    const size_t cb = (size_t)((bh * 2 + dir) * NCH + ch);
    bf16_t* Ul = (bf16_t*)(p.ws + WS_U) + cb * 64 * 128 + nh * 4096 + fr * 16 + (fq & 1) * 512 + (fq >> 1) * 4;
    bf16_t* Wl = (bf16_t*)(p.ws + WS_W) + cb * 64 * 128 + fq * 512; const int wp = invperm16(fr);
    if (isw) {
#pragma unroll
      for (int m = 0; m < 4; ++m)
#pragma unroll
        for (int n = 0; n < 4; ++n)
#pragma unroll
          for (int j = 0; j < 4; ++j) Wl[(m * 16 + j) * 128 + (((((nh * 4 + n) * 2 + (wp >> 3)) ^ (fq * 4 + j)) << 3) | (wp & 7))] = f2bf(-acc[m][n][j]);
    } else {
#pragma unroll
      for (int m = 0; m < 4; ++m)
#pragma unroll
        for (int n = 0; n < 4; ++n) { u32x2 w = {pk2(acc[m][n][0], acc[m][n][1]), pk2(acc[m][n][2], acc[m][n][3])};
          *(u32x2*)(Ul + (n >> 1) * 2048 + (m >> 1) * 1024 + (n & 1) * 256 + 8 * (m & 1)) = w; }
    }
  }
  __syncthreads();
}

constexpr int SC_W = 0, SC_QN = 16384, SC_QK = 32768, SC_KT = 40960, SC_U = 57344, SC_GC = 73728, SC_BUF = 74752;
DI bf16x8 pack8(const f32x16& x, int s) {
  u32x4 w = {pk2(x[8 * s], x[8 * s + 1]), pk2(x[8 * s + 2], x[8 * s + 3]), pk2(x[8 * s + 4], x[8 * s + 5]), pk2(x[8 * s + 6], x[8 * s + 7])};
  return __builtin_bit_cast(bf16x8, w);
}
#define MFMA32(a, b, c) __builtin_amdgcn_mfma_f32_32x32x16_bf16((a), (b), (c), 0, 0, 0)
DI int scan_chunk(int dir, int step) { return dir == 0 ? step : (step < 4 ? 3 - step : 71 - step); }
DI void scan_issue(const Params& p, int bh, int dir, int step, int buf, int ltid) {
  const int ch = scan_chunk(dir, step);
  const size_t cb = (size_t)((bh * 2 + dir) * NCH + ch), cq = (size_t)(bh * NCH + ch);
  const char* Wg = p.ws + WS_W + cb * 16384; const char* Ug = p.ws + WS_U + cb * 16384; const char* QKg = p.ws + WS_QK + cb * 8192;
  const char* GCg = p.ws + WS_GC + cb * 544; const char* QNg = p.ws + WS_QN + cq * 16384; const char* KTg = p.ws + WS_KT + cq * 16384;
  char* dst = smem + buf * SC_BUF; const int o = ltid * 16;
#pragma unroll
  for (int i = 0; i < 4; ++i) {
    __builtin_amdgcn_global_load_lds((const unsigned*)(Wg + o + i * 4096), (unsigned*)(dst + SC_W + o + i * 4096), 16, 0, 0);
    __builtin_amdgcn_global_load_lds((const unsigned*)(QNg + o + i * 4096), (unsigned*)(dst + SC_QN + o + i * 4096), 16, 0, 0);
    __builtin_amdgcn_global_load_lds((const unsigned*)(KTg + o + i * 4096), (unsigned*)(dst + SC_KT + o + i * 4096), 16, 0, 0);
    __builtin_amdgcn_global_load_lds((const unsigned*)(Ug + o + i * 4096), (unsigned*)(dst + SC_U + o + i * 4096), 16, 0, 0); }
#pragma unroll
  for (int i = 0; i < 2; ++i) __builtin_amdgcn_global_load_lds((const unsigned*)(QKg + o + i * 4096), (unsigned*)(dst + SC_QK + o + i * 4096), 16, 0, 0);
  if (ltid < 34) __builtin_amdgcn_global_load_lds((const unsigned*)(GCg + o), (unsigned*)(dst + SC_GC + o), 16, 0, 0);
}
DI void dn_scan_block(const Params& p, int bh, int dir) {
  const int tid = opaque_tid(), wid = __builtin_amdgcn_readfirstlane(tid >> 6), lane = tid & 63, r = lane & 31, hh = lane >> 5;
  const int b = bh >> 2, h = bh & 3, eb = wid & 3;
  const bool loader = wid >= 4;
  f32x16 S[4];
#pragma unroll
  for (int d = 0; d < 4; ++d) S[d] = f32x16{};
  bf16_t* Og = (bf16_t*)(p.ws + (dir == 0 ? WS_OF : WS_OB)) + (size_t)b * TPB * 512 + h * 128 + eb * 32 + r;
  __syncthreads();
  if (loader) { scan_issue(p, bh, dir, 0, 0, tid - 256); asm volatile("s_waitcnt vmcnt(0)" ::: "memory"); }
  __builtin_amdgcn_s_barrier(); asm volatile("" ::: "memory");
#pragma unroll 1
  for (int step = 0; step < NCH; ++step) {
    if (loader) {
      if (step + 1 < NCH) scan_issue(p, bh, dir, step + 1, (step + 1) & 1, tid - 256);
      asm volatile("s_waitcnt vmcnt(0)" ::: "memory");
    } else {
      const char* B = smem + (step & 1) * SC_BUF;
      const int ch = scan_chunk(dir, step);
      bf16x8 Sp[8];
#pragma unroll
      for (int d = 0; d < 4; ++d) { Sp[2 * d] = pack8(S[d], 0); Sp[2 * d + 1] = pack8(S[d], 1); }
      f32x16 VN[2], O[2];
#pragma unroll
      for (int ct = 0; ct < 2; ++ct) { const char* up = B + SC_U + ((eb * 2 + ct) * 64 + lane) * 32;
        const bf16x8 u0 = *(const bf16x8*)up, u1 = *(const bf16x8*)(up + 16);
#pragma unroll
        for (int i = 0; i < 8; ++i) { VN[ct][i] = bf2f((bf16_t)u0[i]); VN[ct][8 + i] = bf2f((bf16_t)u1[i]); }
        O[ct] = f32x16{}; }
#pragma unroll
      for (int ct = 0; ct < 2; ++ct) { const int R = ct * 32 + r;
#pragma unroll
        for (int ks = 0; ks < 8; ++ks) { const int co = (((ks * 2 + hh) ^ (R & 15)) << 4);
          const bf16x8 aw = *(const bf16x8*)(B + SC_W + R * 256 + co); VN[ct] = MFMA32(aw, Sp[ks], VN[ct]);
          const bf16x8 aq = *(const bf16x8*)(B + SC_QN + R * 256 + co); O[ct] = MFMA32(aq, Sp[ks], O[ct]); if (ks == 3 || ks == 7) SBAR(); } }
      const float* GC = (const float*)(B + SC_GC);
#pragma unroll
      for (int ct = 0; ct < 2; ++ct)
#pragma unroll
        for (int q4 = 0; q4 < 4; ++q4) { const f32x4 eg = *(const f32x4*)(GC + ct * 32 + 8 * q4 + 4 * hh);
#pragma unroll
          for (int i = 0; i < 4; ++i) O[ct][q4 * 4 + i] *= eg[i]; }
      bf16x8 Vp[4];
#pragma unroll
      for (int ct = 0; ct < 2; ++ct) { Vp[2 * ct] = pack8(VN[ct], 0); Vp[2 * ct + 1] = pack8(VN[ct], 1); }
#pragma unroll
      for (int ct = 0; ct < 2; ++ct) { const int R = ct * 32 + r;
#pragma unroll
        for (int ks = 0; ks < 4; ++ks) { const bf16x8 a = *(const bf16x8*)(B + SC_QK + R * 128 + (((ks * 2 + hh) ^ ((R >> 1) & 7)) << 4)); O[ct] = MFMA32(a, Vp[ks], O[ct]); } SBAR(); }
      { bf16_t* od = Og + (size_t)(ch * 64) * 512;
#pragma unroll
        for (int ct = 0; ct < 2; ++ct)
#pragma unroll
          for (int i = 0; i < 16; ++i) od[(size_t)(ct * 32 + crow(i, hh)) * 512] = f2bf(O[ct][i]); }
#pragma unroll
      for (int ct = 0; ct < 2; ++ct)
#pragma unroll
        for (int q4 = 0; q4 < 4; ++q4) { const f32x4 ek = *(const f32x4*)(GC + 64 + ct * 32 + 8 * q4 + 4 * hh);
#pragma unroll
          for (int i = 0; i < 4; ++i) VN[ct][q4 * 4 + i] *= ek[i]; }
#pragma unroll
      for (int ct = 0; ct < 2; ++ct) { Vp[2 * ct] = pack8(VN[ct], 0); Vp[2 * ct + 1] = pack8(VN[ct], 1); }
      const float egl = GC[128];
#pragma unroll
      for (int d = 0; d < 4; ++d) { const int R = d * 32 + r;
#pragma unroll
        for (int i = 0; i < 16; ++i) S[d][i] *= egl;
#pragma unroll
        for (int ks = 0; ks < 4; ++ks) { const bf16x8 a = *(const bf16x8*)(B + SC_KT + R * 128 + (((ks * 2 + hh) ^ ((R >> 1) & 7)) << 4)); S[d] = MFMA32(a, Vp[ks], S[d]); } SBAR(); }
      asm volatile("s_waitcnt lgkmcnt(0)" ::: "memory");
    }
    __builtin_amdgcn_s_barrier(); asm volatile("" ::: "memory");
  }
}

#ifndef PROBE_DUP
#define PROBE_DUP 0
#endif
DI void run_attn_unit(const Params& p, int layer, int kind, int id) {
  const bf16_t* P = (const bf16_t*)(p.ws + WS_P); bf16_t* CC = (bf16_t*)(p.ws + WS_HC);
  const bf16_t *Qp, *Kp, *Vp, *Zp; bf16_t* Op; int NT = 4, rlo = 0, rq0 = 0; const float* rp = nullptr;
  if (kind == 0) { const int qb = id & 15, h = (id >> 4) & 7, b = id >> 7; const size_t t0 = (size_t)b * TPB, q0 = t0 + CTX + qb * 256;
    Qp = P + pidx(h, q0); Kp = P + pidx(8 + (h >> 2), t0); Vp = P + pidx(10 + (h >> 2), t0); Zp = P + pidx(12 + h, q0);
    Op = CC + q0 * DM + h * 128; NT = TPB / 64; rq0 = ((((h & 3) * 16 + qb) * 4) % 68);
  } else if (kind == 1) { const int qb = id & 15, h = (id >> 4) & 3, b = id >> 6; const size_t t0 = (size_t)b * TPB, q0 = t0 + CTX + qb * 256;
    rq0 = qb * 4; rlo = min(max(rq0 - 4, 0), 52); NT = 16; rp = p.rpb + (size_t)(layer * 4 + h) * 15 * 31;
    Qp = P + pidx(20 + h, q0); Kp = P + pidx(24 + h, t0); Vp = P + pidx(28 + h, t0); Zp = P + pidx(32 + h, q0);
    Op = CC + q0 * DM + 1024 + h * 128;
  } else if (kind == 2) { const int h = id & 7, b = id >> 3; const size_t t0 = (size_t)b * TPB;
    Qp = P + pidx(h, t0); Kp = P + pidx(8 + (h >> 2), t0); Vp = P + pidx(10 + (h >> 2), t0); Zp = P + pidx(12 + h, t0);
    Op = CC + t0 * DM + h * 128;
  } else { const int h = id & 3, b = id >> 2; const size_t t0 = (size_t)b * TPB;
    Qp = P + pidx(20 + h, t0); Kp = P + pidx(24 + h, t0); Vp = P + pidx(28 + h, t0); Zp = P + pidx(32 + h, t0);
    Op = CC + t0 * DM + 1024 + h * 128;
  }
  if (kind == 1) attn_body<true, 1>(Qp, Kp, Vp, Zp, Op, NT, rlo, rq0, rp);
  else attn_body<false, 2>(Qp, Kp, Vp, Zp, Op, NT, 0, rq0, nullptr);
}
constexpr int AX = 288;
DI void phase_x(const Params& p, int layer, int pass = 0) {
  const int tid = threadIdx.x;
  int* ctr = (int*)(p.ws + WS_CTR) + layer * 2 + pass * 4;
  int* s_unit = (int*)(smem + LDS_BYTES - 16);
  const int total = AX + 16 * NCH + 256 + (layer == 0 ? 16 : 0);
  for (;;) {
    __syncthreads();
    if (tid == 0) *s_unit = atomicAdd(ctr, 1);
    __syncthreads();
    const int u = *s_unit;
    if (u >= total) break;
    if (u < AX) run_attn_unit(p, layer, 0, u);
    else if (u < AX + 16 * NCH) dn_prep(p, layer, u - AX);
    else if (u < AX + 16 * NCH + 256) run_attn_unit(p, layer, 1, u - AX - 16 * NCH);
    else run_attn_unit(p, layer, 3, u - AX - 16 * NCH - 256);
  }
}
DI void phase_y(const Params& p, int layer, int pass = 0) {
  const int tid = threadIdx.x;
  if (blockIdx.x < 32) dn_scan_block(p, blockIdx.x >> 1, blockIdx.x & 1);
  int* ctr = (int*)(p.ws + WS_CTR) + layer * 2 + 1 + pass * 4;
  int* s_unit = (int*)(smem + LDS_BYTES - 16);
  const int total = (512 - AX) + (layer == 0 ? 32 : 0);
  for (;;) {
    __syncthreads();
    if (tid == 0) *s_unit = atomicAdd(ctr, 1);
    __syncthreads();
    const int u = *s_unit;
    if (u >= total) break;
    if (u < 512 - AX) run_attn_unit(p, layer, 0, AX + u);
    else run_attn_unit(p, layer, 2, u - (512 - AX));
  }
}

DI void phase_yc(const Params& p, int layer) {
  const bf16_t* OF = (const bf16_t*)(p.ws + WS_OF); const bf16_t* OB = (const bf16_t*)(p.ws + WS_OB);
  const bf16_t* P = (const bf16_t*)(p.ws + WS_P); bf16_t* CC = (bf16_t*)(p.ws + WS_HC);
  const float* on = p.o_norm + layer * HD;
  const int l16 = threadIdx.x & 15, stride = gridDim.x * 32;
  for (int it0 = blockIdx.x * 32 + (threadIdx.x >> 4); it0 < MTOK * 4; it0 += stride * 4) {
    bf16x8 av[4], bv[4], zv[4];
#pragma unroll
    for (int k = 0; k < 4; ++k) { const int it = it0 + k * stride; av[k] = (bf16x8){0, 0, 0, 0, 0, 0, 0, 0}; bv[k] = av[k]; zv[k] = av[k];
      if (it < MTOK * 4) { const int tok = it >> 2, h = it & 3; const size_t o = (size_t)tok * 512 + h * 128 + l16 * 8;
        av[k] = *(const bf16x8*)(OF + o); bv[k] = *(const bf16x8*)(OB + o); zv[k] = *(const bf16x8*)(P + pidx(48 + h, tok) + l16 * 8); } }
#pragma unroll
    for (int k = 0; k < 4; ++k) { const int it = it0 + k * stride; const int tok = it >> 2, h = it & 3;
      float y[8]; float ss = 0.f;
#pragma unroll
      for (int e = 0; e < 8; ++e) { y[e] = bf2f((bf16_t)av[k][e]) + bf2f((bf16_t)bv[k][e]); ss += y[e] * y[e]; }
      ss += __shfl_xor(ss, 1); ss += __shfl_xor(ss, 2); ss += __shfl_xor(ss, 4); ss += __shfl_xor(ss, 8);
      const float rs = rsqrtf(ss * (1.f / 128.f) + EPS);
#pragma unroll
      for (int e = 0; e < 8; ++e) y[e] = y[e] * rs * on[l16 * 8 + e] * bf2f((bf16_t)zv[k][e]);
      if (it < MTOK * 4) { u32x4 w = {pk2(y[0], y[1]), pk2(y[2], y[3]), pk2(y[4], y[5]), pk2(y[6], y[7])};
        *(u32x4*)(CC + (size_t)tok * DM + 1536 + h * 128 + l16 * 8) = w; } }
  }
}

#define XB_TMO      128
#define XB_XCNT(j)  (256  + 64 * (j))
#define XB_XSUB(j)  (1280 + 64 * (j))
#define XB_XGEN(j)  (2304 + 64 * (j))
#define XB_TOP      3328
#define XB_TOPGEN   3392
#define XCD_BAR_WORDS 3456
#define XB_SPIN_CAP (1u << 18)
#define LAS __attribute__((address_space(3)))

__device__ __forceinline__ unsigned xb_ld(unsigned* p)              { return __hip_atomic_load(p, __ATOMIC_RELAXED, __HIP_MEMORY_SCOPE_AGENT); }
__device__ __forceinline__ unsigned xb_add(unsigned* p, unsigned v) { return __hip_atomic_fetch_add(p, v, __ATOMIC_RELAXED, __HIP_MEMORY_SCOPE_AGENT); }
__device__ __forceinline__ unsigned xb_xcc_id() { return (unsigned)__builtin_amdgcn_s_getreg((3 << 11) | 20) & 0xFu; }
#define XB_SPIN(cond, bar) do { unsigned _sp = 0; while (cond) { __builtin_amdgcn_s_sleep(1); \
    if ((++_sp & 255u) == 0u) { if (xb_ld(&(bar)[XB_TMO])) break; if (_sp > XB_SPIN_CAP) { atomicAdd(&(bar)[XB_TMO], 1u); break; } } } } while (0)

struct XcdBarrier {
    unsigned* bar; unsigned x;
    volatile LAS unsigned* st;
};

__device__ __forceinline__ XcdBarrier xcd_barrier_post(unsigned* bar, volatile LAS unsigned* st) {
    XcdBarrier b; b.bar = bar; b.x = xb_xcc_id(); b.st = st;
    if (threadIdx.x == 0) (void)xb_add(&bar[XB_XCNT(b.x)], 1u);
    return b;
}
__device__ __forceinline__ void xcd_barrier_complete(unsigned* bar, unsigned x, unsigned& nloc, unsigned& nx) {
    const unsigned G = gridDim.x * gridDim.y * gridDim.z;
    unsigned sum, cnt, mine, sp = 0u;
    for (;;) {
        sum = 0u; cnt = 0u; mine = 0u;
#pragma unroll
        for (unsigned j = 0; j < 16; ++j) { const unsigned c = xb_ld(&bar[XB_XCNT(j)]); sum += c; cnt += (c > 0u) ? 1u : 0u; mine = (j == x) ? c : mine; }
        if (sum == G) break;
        __builtin_amdgcn_s_sleep(1);
        if ((++sp & 255u) == 0u) { if (xb_ld(&bar[XB_TMO])) break; if (sp > XB_SPIN_CAP) { atomicAdd(&bar[XB_TMO], 1u); break; } }
    }
    nloc = mine > 0u ? mine : 1u; nx = cnt > 0u ? cnt : 1u;
}

__device__ __forceinline__ void xcd_barrier(const XcdBarrier& b) {
    asm volatile("s_waitcnt vmcnt(0)" ::: "memory");
    __syncthreads();
    if (threadIdx.x == 0) {
        unsigned* bar = b.bar;
        __builtin_amdgcn_s_waitcnt(0);
        unsigned nloc = b.st[0], nx = b.st[1];
        if (nloc == 0u) { xcd_barrier_complete(bar, b.x, nloc, nx); b.st[0] = nloc; b.st[1] = nx; }
        const unsigned old = xb_add(&bar[XB_XSUB(b.x)], 1u);
        const unsigned gen = old / nloc;
        if (old + 1u == (gen + 1u) * nloc) {
            __builtin_amdgcn_fence(__ATOMIC_RELEASE, "agent");
            asm volatile("s_waitcnt vmcnt(0)" ::: "memory");
            const unsigned og = xb_add(&bar[XB_TOP], 1u);
            const unsigned tg = og / nx;
            if (og + 1u == (tg + 1u) * nx) xb_add(&bar[XB_TOPGEN], 1u);
            else XB_SPIN(xb_ld(&bar[XB_TOPGEN]) == tg, bar);
            __builtin_amdgcn_fence(__ATOMIC_ACQUIRE, "agent");
            xb_add(&bar[XB_XGEN(b.x)], 1u);
            asm volatile("s_waitcnt vmcnt(0)" ::: "memory");
        } else {
            XB_SPIN(xb_ld(&bar[XB_XGEN(b.x)]) == gen, bar);
            __builtin_amdgcn_fence(__ATOMIC_ACQUIRE, "agent");
            asm volatile("s_waitcnt vmcnt(0)" ::: "memory");
        }
    }
    __syncthreads();
}


DI void gsync(const Params& p) { XcdBarrier xb; xb.bar = (unsigned*)(p.ws + WS_BAR); xb.x = xb_xcc_id(); xb.st = (volatile LAS unsigned*)(smem + LDS_BYTES - 32); xcd_barrier(xb); }
template <int LAYER>
DI void layer_phases(const Params& p) {
  constexpr int B0 = 1 + 7 * LAYER;
#define PH_ON(k) (p.ph_lo <= (k) && (k) <= p.ph_hi)
#define PH_SYNC(k) do { if (p.ph_lo <= (k) && (k) < p.ph_hi) gsync(p); } while (0)
  if (PH_ON(B0 + 0)) { phase_rows(p, LAYER); phase_convert(p, LAYER); }
  PH_SYNC(B0 + 0);
  if (PH_ON(B0 + 1)) { phase_gemm1(p, LAYER); phase_gates(p); }
  PH_SYNC(B0 + 1);
  if (PH_ON(B0 + 2)) phase_qknorm(p, LAYER);
  PH_SYNC(B0 + 2);
  if (PH_ON(B0 + 3)) phase_x(p, LAYER);
  PH_SYNC(B0 + 3);
  if (PH_ON(B0 + 4)) phase_y(p, LAYER);
  PH_SYNC(B0 + 4);
  if (PH_ON(B0 + 5)) phase_yc(p, LAYER);
  PH_SYNC(B0 + 5);
  if (PH_ON(B0 + 6)) phase_gemm2(p, LAYER);
  PH_SYNC(B0 + 6);
}
__global__ void __launch_bounds__(512) fwd_megakernel(Params p) {
  cg::grid_group grid = cg::this_grid();
  volatile LAS unsigned* st = (volatile LAS unsigned*)(smem + LDS_BYTES - 32);
  unsigned* bar = (unsigned*)(p.ws + WS_BAR);
  if (threadIdx.x == 0) { st[0] = 0u; st[1] = 0u; }
  if (blockIdx.x == 0) { for (int i = threadIdx.x; i < XCD_BAR_WORDS; i += 512) bar[i] = 0u; }
  if (PH_ON(0)) phase_mod(p);
  grid.sync();
  (void)xcd_barrier_post(bar, st);
  layer_phases<0>(p);
  layer_phases<1>(p);
  if (PH_ON(15)) phase_final_ln(p);
}

extern "C" void kernel_launch(void* const* d_in, const int* in_sizes, int n_in, void* d_out, int out_size, void* d_ws, size_t ws_size, hipStream_t stream) {
  static int grid_blocks = 0;
  if (!grid_blocks) {
    if (ws_size < WS_END) { fprintf(stderr, "kernel_launch: workspace too small: %zu < %zu\n", ws_size, (size_t)WS_END); return; }
    if (hipFuncSetAttribute((const void*)fwd_megakernel, hipFuncAttributeMaxDynamicSharedMemorySize, LDS_BYTES) != hipSuccess) { fprintf(stderr, "kernel_launch: LDS attribute failed\n"); return; }
    int dev = 0, cus = 0, per_cu = 0;
    hipGetDevice(&dev);
    hipDeviceGetAttribute(&cus, hipDeviceAttributeMultiprocessorCount, dev);
    hipOccupancyMaxActiveBlocksPerMultiprocessor(&per_cu, fwd_megakernel, 512, LDS_BYTES);
    if (per_cu < 1) { fprintf(stderr, "kernel_launch: occupancy query returned %d\n", per_cu); return; }
    grid_blocks = cus;
  }
  Params p{};
  p.x = (const float*)d_in[0]; p.c = (const float*)d_in[1]; p.ctx = (const float*)d_in[2]; p.c_ctx = (const float*)d_in[3];
  p.w_mod = (const float*)d_in[4]; p.b_mod = (const float*)d_in[5]; p.w_in = (const float*)d_in[6]; p.q_norm = (const float*)d_in[7];
  p.k_norm = (const float*)d_in[8]; p.rpb = (const float*)d_in[9]; p.conv_w = (const float*)d_in[10]; p.a_log = (const float*)d_in[11];
  p.dt_bias = (const float*)d_in[12]; p.o_norm = (const float*)d_in[13]; p.w_out = (const float*)d_in[14]; p.ln_g = (const float*)d_in[15]; p.ln_b = (const float*)d_in[16];
  p.out = (float*)d_out; p.ws = (char*)d_ws; p.ph_lo = 0; p.ph_hi = 15;
  void* args[] = {&p};
  hipError_t e = hipLaunchCooperativeKernel((void*)fwd_megakernel, dim3(grid_blocks), dim3(512), args, LDS_BYTES, stream);
  if (e != hipSuccess) fprintf(stderr, "cooperative launch failed: %s (grid %d)\n", hipGetErrorString(e), grid_blocks);
}
```

```cpp
#include <hip/hip_runtime.h>
#include <hip/hip_cooperative_groups.h>
#include <cstdio>
#include <cstdint>
namespace cg = cooperative_groups;

#define DI __device__ __forceinline__
typedef unsigned short bf16_t;
using bf16x8 = __attribute__((ext_vector_type(8))) short;
using s16x4  = __attribute__((ext_vector_type(4))) short;
using f32x4  = __attribute__((ext_vector_type(4))) float;
using f32x16 = __attribute__((ext_vector_type(16))) float;
using u32x4  = __attribute__((ext_vector_type(4))) unsigned;
using u32x2  = __attribute__((ext_vector_type(2))) unsigned;

constexpr int DM = 2048, NBATCH = 4, SEQ = 4096, CTX = 256, TPB = 4352  , MTOK = NBATCH * TPB;
constexpr int INW = 6672, NP = 6784  , NPW = 6656  , HD = 128;
constexpr int C_QA = 0, C_KA = 1024, C_VA = 1280, C_ZA = 1536, C_QB = 2560, C_KB = 3072, C_VB = 3584, C_ZB = 4096, C_QC = 4608, C_ZC = 6144;
constexpr int NCH = 68;
constexpr float EPS = 1e-6f;
constexpr float ALPHA = 1.4142135623730951f;

constexpr size_t al256(size_t x) { return (x + 255) / 256 * 256; }
constexpr size_t WS_MOD  = 0;
constexpr size_t WS_CTR  = al256(WS_MOD + 2 * 5 * 6144 * 4);
constexpr size_t WS_BAR  = WS_CTR + 256;
constexpr size_t WS_WINT = al256(WS_BAR + 3456 * 4);
constexpr size_t WS_WG   = al256(WS_WINT + (size_t)NPW * DM * 2);
constexpr size_t WS_WOUT = al256(WS_WG + (size_t)64 * DM * 2);
constexpr size_t WS_HC   = al256(WS_WOUT + (size_t)DM * DM * 2);
constexpr size_t WS_P    = al256(WS_HC + (size_t)MTOK * DM * 2);
constexpr size_t WS_GT   = al256(WS_P + (size_t)MTOK * NP * 2);
constexpr size_t WS_CTX1 = al256(WS_GT + (size_t)MTOK * 16 * 4);
constexpr size_t WS_OF   = al256(WS_CTX1 + (size_t)NBATCH * CTX * DM * 4);
constexpr size_t WS_OB   = al256(WS_OF + (size_t)MTOK * 512 * 2);
constexpr size_t WS_QN   = al256(WS_OB + (size_t)MTOK * 512 * 2);
constexpr size_t WS_KT   = al256(WS_QN + (size_t)16 * NCH * 64 * 128 * 2);
constexpr size_t WS_W    = al256(WS_KT + (size_t)16 * NCH * 64 * 128 * 2);
constexpr size_t WS_U    = al256(WS_W + (size_t)32 * NCH * 64 * 128 * 2);
constexpr size_t WS_QK   = al256(WS_U + (size_t)32 * NCH * 64 * 128 * 2);
constexpr size_t WS_GC   = al256(WS_QK + (size_t)32 * NCH * 64 * 64 * 2);
constexpr size_t WS_END  = al256(WS_GC + (size_t)32 * NCH * 136 * 4);

constexpr int LDS_BYTES = 150016;

struct Params {
  const float *x, *c, *ctx, *c_ctx, *w_mod, *b_mod, *w_in, *q_norm, *k_norm, *rpb, *conv_w, *a_log, *dt_bias, *o_norm, *w_out, *ln_g, *ln_b;
  float* out; char* ws;
  int ph_lo, ph_hi;
};

extern __shared__ __attribute__((aligned(16))) char smem[];

DI bf16_t f2bf(float x) { unsigned u = __float_as_uint(x); u += 0x7fffu + ((u >> 16) & 1u); return (bf16_t)(u >> 16); }
DI float bf2f(bf16_t v) { return __uint_as_float(((unsigned)v) << 16); }
typedef __bf16 bf16v2 __attribute__((ext_vector_type(2)));
typedef float f32v2 __attribute__((ext_vector_type(2)));
DI unsigned pk2(float lo, float hi) { f32v2 v = {lo, hi}; return __builtin_bit_cast(unsigned, __builtin_convertvector(v, bf16v2)); }
DI float wave_sum(float v) { for (int o = 32; o; o >>= 1) v += __shfl_xor(v, o); return v; }
DI float silu_f(float v) { return v / (1.f + __expf(-v)); }
DI int invperm16(int off) { return 8 * ((off >> 2) & 1) + (off & 3) + 4 * (off >> 3); }
DI int perm_k(int k) { return (k & ~15) | invperm16(k & 15); }
DI int opaque_tid() { int t = threadIdx.x; asm volatile("" : "+v"(t)); return t; }
DI size_t pidx(int hidx, size_t tok) { return ((size_t)hidx * MTOK + tok) * 128; }
DI int crow(int r, int hi) { return (r & 3) + 8 * (r >> 2) + 4 * hi; }

DI void phase_mod(const Params& p) {
  const int tid = threadIdx.x;
  float* sc = (float*)smem;
  float* red = (float*)(smem + 40960);
  if (blockIdx.x == 0 && tid < 8) ((int*)(p.ws + WS_CTR))[tid] = 0;
  for (int i = tid; i < 5 * 2048; i += 512) { float v = i < 4 * 2048 ? p.c[i] : p.c_ctx[i - 4 * 2048]; sc[i] = silu_f(v); }
  __syncthreads();
  float* MOD = (float*)(p.ws + WS_MOD);
  for (int t = blockIdx.x; t < 192; t += gridDim.x) {
    const int layer = t / 96, cg0 = (t % 96) * 64;
    const int cl = tid & 15, ks = tid >> 4;
    const float* W = p.w_mod + (size_t)layer * DM * 6144 + cg0 + cl * 4;
    f32x4 a[5]; for (int r = 0; r < 5; ++r) a[r] = (f32x4){0.f, 0.f, 0.f, 0.f};
    for (int k = ks * 64; k < ks * 64 + 64; ++k) {
      const f32x4 w = *(const f32x4*)(W + (size_t)k * 6144);
#pragma unroll
      for (int r = 0; r < 5; ++r) a[r] += w * sc[r * 2048 + k];
    }
#pragma unroll
    for (int r = 0; r < 5; ++r) *(f32x4*)(red + (ks * 5 + r) * 64 + cl * 4) = a[r];
    __syncthreads();
    if (tid < 320) { const int r = tid >> 6, cc = tid & 63; float s = 0.f; for (int k2 = 0; k2 < 32; ++k2) s += red[(k2 * 5 + r) * 64 + cc];
      MOD[(layer * 5 + r) * 6144 + cg0 + cc] = s + p.b_mod[layer * 6144 + cg0 + cc]; }
    __syncthreads();
  }
}

DI void ln_stats(const f32x4 (&v)[8], float& mean, float& rstd) {
  float s = 0.f;
#pragma unroll
  for (int i = 0; i < 8; ++i) s += (v[i][0] + v[i][1]) + (v[i][2] + v[i][3]);
  s = wave_sum(s); mean = s * (1.f / 2048.f);
  float q = 0.f;
#pragma unroll
  for (int i = 0; i < 8; ++i) { f32x4 d = v[i] - mean; q += (d[0] * d[0] + d[1] * d[1]) + (d[2] * d[2] + d[3] * d[3]); }
  q = wave_sum(q); rstd = rsqrtf(q * (1.f / 2048.f) + EPS);
}

DI void phase_rows(const Params& p, int layer) {
  const int tid = threadIdx.x, wid = tid >> 6, lane = tid & 63;
  const float* MOD = (const float*)(p.ws + WS_MOD) + layer * 5 * 6144;
  bf16_t* H = (bf16_t*)(p.ws + WS_HC);
  float* CTX1 = (float*)(p.ws + WS_CTX1);
  for (int row = blockIdx.x * 8 + wid; row < MTOK; row += gridDim.x * 8) {
    const int b = row / TPB, tin = row % TPB; const bool isctx = tin < CTX;
    const float* src = isctx ? p.ctx + (size_t)(b * CTX + tin) * DM : p.x + (size_t)(b * SEQ + tin - CTX) * DM;
    f32x4 v[8];
#pragma unroll
    for (int i = 0; i < 8; ++i) v[i] = *(const f32x4*)(src + i * 256 + lane * 4);
    float mean, rstd;
    if (layer > 0) {
      const bf16_t* yr = (const bf16_t*)(p.ws + WS_P) + (size_t)row * DM;
      float* dst = isctx ? CTX1 + (size_t)(b * CTX + tin) * DM : p.out + (size_t)(b * SEQ + tin - CTX) * DM;
#pragma unroll
      for (int i = 0; i < 8; ++i) { const u32x2 yw = *(const u32x2*)(yr + i * 256 + lane * 4);
        const f32x4 yv = {__uint_as_float(yw.x << 16), __uint_as_float(yw.x & 0xffff0000u), __uint_as_float(yw.y << 16), __uint_as_float(yw.y & 0xffff0000u)};
        v[i] = v[i] * ALPHA + yv; }
      ln_stats(v, mean, rstd);
      const float* g = p.ln_g + (layer - 1) * DM; const float* bb = p.ln_b + (layer - 1) * DM;
#pragma unroll
      for (int i = 0; i < 8; ++i) { const f32x4 gg = *(const f32x4*)(g + i * 256 + lane * 4), b4 = *(const f32x4*)(bb + i * 256 + lane * 4);
        v[i] = (v[i] - mean) * rstd * gg + b4; if (!isctx) *(f32x4*)(dst + i * 256 + lane * 4) = v[i]; }
    }
    ln_stats(v, mean, rstd);
    const float* mr = MOD + (isctx ? 4 : b) * 6144;
#pragma unroll
    for (int i = 0; i < 8; ++i) { const int col = i * 256 + lane * 4;
      const f32x4 sh = *(const f32x4*)(mr + col), scl = *(const f32x4*)(mr + 2048 + col);
      const f32x4 h = (v[i] - mean) * rstd * (scl + 1.f) + sh;
      u32x2 w; w.x = pk2(h[0], h[1]); w.y = pk2(h[2], h[3]);
      *(u32x2*)(H + (size_t)row * DM + col) = w; }
  }
}

DI void phase_final_ln(const Params& p) {
  const int tid = threadIdx.x, wid = tid >> 6, lane = tid & 63;
  const float* g = p.ln_g + DM; const float* bb = p.ln_b + DM;
  for (int row = blockIdx.x * 8 + wid; row < NBATCH * SEQ; row += gridDim.x * 8) {
    float* src = p.out + (size_t)row * DM;
    const bf16_t* yr = (const bf16_t*)(p.ws + WS_P) + ((size_t)(row / SEQ) * TPB + CTX + row % SEQ) * DM;
    f32x4 v[8];
#pragma unroll
    for (int i = 0; i < 8; ++i) { const u32x2 yw = *(const u32x2*)(yr + i * 256 + lane * 4);
      const f32x4 yv = {__uint_as_float(yw.x << 16), __uint_as_float(yw.x & 0xffff0000u), __uint_as_float(yw.y << 16), __uint_as_float(yw.y & 0xffff0000u)};
      v[i] = *(const f32x4*)(src + i * 256 + lane * 4) * ALPHA + yv; }
    float mean, rstd; ln_stats(v, mean, rstd);
#pragma unroll
    for (int i = 0; i < 8; ++i) { const f32x4 gg = *(const f32x4*)(g + i * 256 + lane * 4), b4 = *(const f32x4*)(bb + i * 256 + lane * 4);
      *(f32x4*)(src + i * 256 + lane * 4) = (v[i] - mean) * rstd * gg + b4; }
  }
}

DI void convert_weight(const float* W, int N, int ntn, bf16_t* WT, int t, int nbase) {
  const int tid = threadIdx.x;
  float* tile = (float*)smem;
  const int n0 = nbase + (t % ntn) * 64, k0 = (t / ntn) * 64;
  { const int kr = tid >> 4, c4 = (tid & 15) * 4;
#pragma unroll
    for (int pss = 0; pss < 2; ++pss) { const int k = kr + pss * 32;
      f32x4 w = (f32x4){0.f, 0.f, 0.f, 0.f};
      if (n0 + c4 < N) w = *(const f32x4*)(W + (size_t)(k0 + k) * N + n0 + c4);
      tile[k * 65 + c4] = w[0]; tile[k * 65 + c4 + 1] = w[1]; tile[k * 65 + c4 + 2] = w[2]; tile[k * 65 + c4 + 3] = w[3]; } }
  __syncthreads();
  { const int n = tid >> 3, k8 = (tid & 7) * 8;
    u32x4 w; w.x = pk2(tile[(k8 + 0) * 65 + n], tile[(k8 + 1) * 65 + n]); w.y = pk2(tile[(k8 + 2) * 65 + n], tile[(k8 + 3) * 65 + n]);
    w.z = pk2(tile[(k8 + 4) * 65 + n], tile[(k8 + 5) * 65 + n]); w.w = pk2(tile[(k8 + 6) * 65 + n], tile[(k8 + 7) * 65 + n]);
    *(u32x4*)(WT + (size_t)(n0 - nbase + n) * DM + k0 + k8) = w; }
  __syncthreads();
}
DI void phase_convert(const Params& p, int layer) {
  const int T1 = (NPW / 64) * 32, T2 = 32 * 32, T3 = 32;
  for (int t = blockIdx.x; t < T1 + T2 + T3; t += gridDim.x) {
    if (t < T1) convert_weight(p.w_in + (size_t)layer * DM * INW, INW, NPW / 64, (bf16_t*)(p.ws + WS_WINT), t, 0);
    else if (t < T1 + T2) convert_weight(p.w_out + (size_t)layer * DM * DM, DM, 32, (bf16_t*)(p.ws + WS_WOUT), t - T1, 0);
    else convert_weight(p.w_in + (size_t)layer * DM * INW, INW, 1, (bf16_t*)(p.ws + WS_WG), t - T1 - T2, NPW);
  }
}

namespace pg8 {
#define PG8_LAS __attribute__((address_space(3)))
typedef unsigned short bf16_t;
typedef short bf16x8 __attribute__((ext_vector_type(8)));
typedef float f32x4 __attribute__((ext_vector_type(4)));
typedef unsigned u32x4 __attribute__((ext_vector_type(4)));
constexpr int BM = 256, BK = 64, HALF = 128, HTB = HALF * BK * 2  , STAGE_BYTES = 8 * HTB, NXCD = 8, WGM = 8;

__host__ __device__ __forceinline__ int lds_byte(int r, int c) { const int st = (r >> 4) * 2 + (c >> 5), rr = r & 15, cc = c & 31, ob = rr * 64 + cc * 2; return st * 1024 + (ob ^ (((ob >> 9) & 1) << 5)); }
__host__ __device__ __forceinline__ void stage_rc(int b, int& R, int& C) { const int st = b / 1024, sb = b % 1024, swz = sb ^ (((sb >> 9) & 1) << 5); R = (st >> 1) * 16 + swz / 64; C = (st & 1) * 32 + (swz % 64) / 2; }
__host__ __device__ __forceinline__ int perm32(int rho) { const int n = rho >> 4, i = rho & 15; return 8 * (i >> 2) + 4 * n + (i & 3); }

struct Unit { int pm, pn; };
struct Gemm { const bf16_t* A; const bf16_t* Bt; int M, N, K; };

struct StaticOrder {
    int nM, nN, nwg, G, c;
    __host__ __device__ void init(int M, int N, int G_, int c_) { nM = M / BM; nN = N / BM; nwg = nM * nN; G = G_; c = c_; }
    __host__ __device__ bool next(int i, Unit& u) const {
        const long L = (long)i * G + c; if (L >= nwg) return false;
        int wgid = (int)L; { const int q = nwg / NXCD, r = nwg % NXCD, xcd = wgid % NXCD, off = wgid / NXCD; wgid = (xcd < r ? xcd * (q + 1) : r * (q + 1) + (xcd - r) * q) + off; }
        const int nig = WGM * nN, gid = wgid / nig, fm = gid * WGM, gsz = (nM - fm) < WGM ? (nM - fm) : WGM;
        u.pm = fm + ((wgid % nig) % gsz); u.pn = (wgid % nig) / gsz; return true;
    }
    __device__ __forceinline__ void a_ready(const Unit&) const {}
    __device__ __forceinline__ void done(const Unit&) const {}
};

template <class Epi, class Sched, bool STAMP = false>
__device__ __forceinline__ void gemm_phase(PG8_LAS unsigned char* lds, const Gemm g, const Sched& S, const Epi& E, unsigned long long* stamps) {
    const int tid = threadIdx.x, wid = __builtin_amdgcn_readfirstlane(tid >> 6), lane = tid & 63, wr = wid >> 2, wc = wid & 3, fr = lane & 15, fq = lane >> 4;
    const int K = g.K, nt = K / BK;
    int ts_lo = 0, ts_hi = 0, nts = 0; const unsigned long long rt_entry = STAMP ? (unsigned long long)wall_clock64() : 0ull;
#define PG8_STAMP() do { if (STAMP && wid == 0 && nts < 64) { const unsigned long long _c = (unsigned long long)clock64(); \
        ts_lo = (lane == nts) ? (int)(unsigned)_c : ts_lo; ts_hi = (lane == nts) ? (int)(unsigned)(_c >> 32) : ts_hi; ++nts; } } while (0)
    PG8_STAMP();
    unsigned voffA[2], voffB[2];
#pragma unroll
    for (int i = 0; i < 2; ++i) { int R, C; stage_rc(tid * 16 + i * 8192, R, C); const int Rb = Epi::PERM ? ((R & ~31) + perm32(R & 31)) : R;
        voffA[i] = (unsigned)(R * K + C) * 2u; voffB[i] = (unsigned)(Rb * K + C) * 2u; }
    const size_t kstep = (size_t)(BK * 2);
    const size_t hstep = (size_t)HALF * K * 2;
    const size_t tstep = 2 * hstep;
    const unsigned ldsw = (unsigned)wid * 1024u;
    const int aoff = lds_byte(wr * 64 + fr, fq * 8), boff = lds_byte(wc * 32 + fr, fq * 8);
#define PG8_SA(b, h) (((b) * 2 + (h)) * HTB)
#define PG8_SB(b, h) ((4 + (b) * 2 + (h)) * HTB)
#define PG8_STAGE(bufoff, gbase, voff) do { _Pragma("unroll") for (int _i = 0; _i < 2; ++_i) \
        __builtin_amdgcn_global_load_lds((const unsigned*)((const char*)(gbase) + (voff)[_i]), (PG8_LAS unsigned*)(lds + (bufoff) + ldsw + _i * 8192), 16, 0, 0); } while (0)
#define PG8_LDA(dst, b, h) do { _Pragma("unroll") for (int m = 0; m < 4; ++m) _Pragma("unroll") for (int k = 0; k < 2; ++k) dst[m][k] = *(const PG8_LAS bf16x8*)(lds + PG8_SA(b, h) + aoff + m * 2048 + k * 1024); } while (0)
#define PG8_LDB(dst, b, h) do { _Pragma("unroll") for (int n = 0; n < 2; ++n) _Pragma("unroll") for (int k = 0; k < 2; ++k) dst[n][k] = *(const PG8_LAS bf16x8*)(lds + PG8_SB(b, h) + boff + n * 2048 + k * 1024); } while (0)
#define PG8_MMA(ai, bj, At, Bt) do { __builtin_amdgcn_s_setprio(1); _Pragma("unroll") for (int m = 0; m < 4; ++m) _Pragma("unroll") for (int n = 0; n < 2; ++n) _Pragma("unroll") for (int k = 0; k < 2; ++k) \
        acc[ai][bj][m][n] = __builtin_amdgcn_mfma_f32_16x16x32_bf16(Bt[n][k], At[m][k], acc[ai][bj][m][n], 0, 0, 0); __builtin_amdgcn_s_setprio(0); } while (0)
#define PG8_WAIT_V(n) asm volatile("s_waitcnt vmcnt(" #n ")" ::: "memory")
#define PG8_WAIT_L(n) asm volatile("s_waitcnt lgkmcnt(" #n ")" ::: "memory")
#define PG8_BAR __builtin_amdgcn_s_barrier()
#define PG8_SCHED __builtin_amdgcn_sched_barrier(0)
    Unit cur, nxt; int ui = 0;
    if (!S.next(0, cur)) return;
    f32x4 acc[2][2][4][2];
#pragma unroll
    for (int a = 0; a < 2; ++a)
#pragma unroll
        for (int b = 0; b < 2; ++b)
#pragma unroll
            for (int m = 0; m < 4; ++m)
#pragma unroll
                for (int n = 0; n < 2; ++n) acc[a][b][m][n] = (f32x4){0.f, 0.f, 0.f, 0.f};
    bf16x8 At[4][2], B0[2][2], B1[2][2];
    const char* cA = (const char*)g.A + (size_t)cur.pm * tstep; const char* cB = (const char*)g.Bt + (size_t)cur.pn * tstep;
    S.a_ready(cur);
    PG8_STAGE(PG8_SB(0, 0), cB, voffB); PG8_STAGE(PG8_SA(0, 0), cA, voffA); PG8_STAGE(PG8_SB(0, 1), cB + hstep, voffB); PG8_STAGE(PG8_SA(0, 1), cA + hstep, voffA);
    if (wr == 1) PG8_BAR;
    PG8_WAIT_V(4); PG8_BAR;
    PG8_STAGE(PG8_SB(1, 0), cB + kstep, voffB); PG8_STAGE(PG8_SA(1, 0), cA + kstep, voffA); PG8_STAGE(PG8_SB(1, 1), cB + hstep + kstep, voffB);
    PG8_WAIT_V(6); PG8_BAR;
    PG8_STAMP();
    for (;;) {
        const bool has_next = S.next(ui + 1, nxt);
        const char* nA = has_next ? (const char*)g.A + (size_t)nxt.pm * tstep : cA; const char* nB = has_next ? (const char*)g.Bt + (size_t)nxt.pn * tstep : cB;
        for (int t = 0; t < nt; t += 2) {
            const bool last = (t == nt - 2);
            const char* a1 = cA + (size_t)(t + 1) * kstep;
            const char* a2 = last ? nA : cA + (size_t)(t + 2) * kstep; const char* b2 = last ? nB : cB + (size_t)(t + 2) * kstep;
            const char* a3 = a2 + kstep; const char* b3 = b2 + kstep;
            if (last && has_next) S.a_ready(nxt);
            PG8_LDB(B0, 0, 0); PG8_SCHED; PG8_LDA(At, 0, 0); PG8_STAGE(PG8_SA(1, 1), a1 + hstep, voffA);
            PG8_WAIT_L(8); PG8_BAR; PG8_WAIT_L(0); PG8_MMA(0, 0, At, B0); PG8_BAR; PG8_SCHED;
            PG8_LDB(B1, 0, 1); PG8_STAGE(PG8_SB(0, 0), b2, voffB);
            PG8_BAR; PG8_WAIT_L(0); PG8_MMA(0, 1, At, B1); PG8_BAR;
            PG8_LDA(At, 0, 1); PG8_STAGE(PG8_SA(0, 0), a2, voffA);
            PG8_BAR; PG8_WAIT_L(0); PG8_MMA(1, 0, At, B0); PG8_BAR; PG8_SCHED;
            PG8_STAGE(PG8_SB(0, 1), b2 + hstep, voffB);
            PG8_WAIT_V(6); PG8_BAR; PG8_MMA(1, 1, At, B1); PG8_BAR;
            PG8_LDB(B0, 1, 0); PG8_SCHED; PG8_LDA(At, 1, 0); PG8_STAGE(PG8_SA(0, 1), a2 + hstep, voffA);
            PG8_WAIT_L(8); PG8_BAR; PG8_WAIT_L(0); PG8_MMA(0, 0, At, B0); PG8_BAR; PG8_SCHED;
            PG8_LDB(B1, 1, 1); PG8_STAGE(PG8_SB(1, 0), b3, voffB);
            PG8_BAR; PG8_WAIT_L(0); PG8_MMA(0, 1, At, B1); PG8_BAR;
            PG8_LDA(At, 1, 1); PG8_STAGE(PG8_SA(1, 0), a3, voffA);
            PG8_BAR; PG8_WAIT_L(0); PG8_MMA(1, 0, At, B0); PG8_BAR; PG8_SCHED;
            PG8_STAGE(PG8_SB(1, 1), b3 + hstep, voffB);
            PG8_WAIT_V(6); PG8_BAR; PG8_MMA(1, 1, At, B1); PG8_BAR;
        }
        PG8_STAMP();
        if constexpr (!Epi::AFTER_DRAIN) { E(acc, cur, wr, wc, fr, fq); S.done(cur); }
        PG8_STAMP();
        if (!has_next) break;
#pragma unroll
        for (int a = 0; a < 2; ++a)
#pragma unroll
            for (int b = 0; b < 2; ++b)
#pragma unroll
                for (int m = 0; m < 4; ++m)
#pragma unroll
                    for (int n = 0; n < 2; ++n) acc[a][b][m][n] = (f32x4){0.f, 0.f, 0.f, 0.f};
        cur = nxt; cA = nA; cB = nB; ++ui;
    }
    PG8_WAIT_V(0);
    if (wr == 0) PG8_BAR;
    PG8_BAR;
    if constexpr (Epi::AFTER_DRAIN) { E.fused(acc, cur, wr, wc, fr, fq, lds, wid, lane); S.done(cur); }
    PG8_STAMP();
    if (STAMP && wid == 0) { stamps[lane] = lane < nts ? (((unsigned long long)(unsigned)ts_hi << 32) | (unsigned)ts_lo) : 0ull;
        if (lane == 62) stamps[62] = rt_entry; if (lane == 63) stamps[63] = (unsigned long long)wall_clock64(); }
#undef PG8_STAMP
#undef PG8_SA
#undef PG8_SB
#undef PG8_STAGE
#undef PG8_LDA
#undef PG8_LDB
#undef PG8_MMA
#undef PG8_WAIT_V
#undef PG8_WAIT_L
#undef PG8_BAR
#undef PG8_SCHED
}
}

struct Epi1 {
  static constexpr bool PERM = true, AFTER_DRAIN = false;
  bf16_t* P;
  DI void operator()(const f32x4 (&acc)[2][2][4][2], const pg8::Unit& u, int wr, int wc, int fr, int fq) const {
    const int row0 = u.pm * 256 + wr * 64 + fr;
#pragma unroll
    for (int bj = 0; bj < 2; ++bj) { const int hidx = u.pn * 2 + bj;
      const bool sl = (hidx >= 12 && hidx < 20) || (hidx >= 32 && hidx < 36) || (hidx >= 48 && hidx < 52);
#pragma unroll
      for (int ai = 0; ai < 2; ++ai)
#pragma unroll
        for (int m = 0; m < 4; ++m) { f32x4 v0 = acc[ai][bj][m][0], v1 = acc[ai][bj][m][1];
          if (sl) { for (int e = 0; e < 4; ++e) { v0[e] = silu_f(v0[e]); v1[e] = silu_f(v1[e]); } }
          u32x4 w = {pk2(v0[0], v0[1]), pk2(v0[2], v0[3]), pk2(v1[0], v1[1]), pk2(v1[2], v1[3])};
          *(u32x4*)(P + pidx(hidx, row0 + ai * 128 + m * 16) + wc * 32 + 8 * fq) = w; } }
  }
};
struct Epi2 {
  static constexpr bool PERM = true, AFTER_DRAIN = false;
  const float* MOD; bf16_t* Y;
  DI void operator()(const f32x4 (&acc)[2][2][4][2], const pg8::Unit& u, int wr, int wc, int fr, int fq) const {
    const int b = u.pm / 17; const bool isctx = (u.pm % 17) == 0;
    const int row0 = u.pm * 256 + wr * 64 + fr, col0 = u.pn * 256 + wc * 32 + 8 * fq;
    const float* gate = MOD + (isctx ? 4 : b) * 6144 + 4096 + col0;
    f32x4 gv[2][2];
#pragma unroll
    for (int bj = 0; bj < 2; ++bj)
#pragma unroll
      for (int n = 0; n < 2; ++n) gv[bj][n] = *(const f32x4*)(gate + bj * 128 + 4 * n);
#pragma unroll
    for (int ai = 0; ai < 2; ++ai)
#pragma unroll
      for (int m = 0; m < 4; ++m) { bf16_t* rowp = Y + (size_t)(row0 + ai * 128 + m * 16) * DM + col0;
#pragma unroll
        for (int bj = 0; bj < 2; ++bj) { const f32x4 v0 = acc[ai][bj][m][0] * gv[bj][0], v1 = acc[ai][bj][m][1] * gv[bj][1];
          u32x4 w = {pk2(v0[0], v0[1]), pk2(v0[2], v0[3]), pk2(v1[0], v1[1]), pk2(v1[2], v1[3])};
          *(u32x4*)(rowp + bj * 128) = w; } }
  }
};
struct LatentOrder : pg8::StaticOrder {
  __device__ bool next(int i, pg8::Unit& u) const { if (!pg8::StaticOrder::next(i, u)) return false; u.pm = (u.pm >> 4) * 17 + 1 + (u.pm & 15); return true; }
};
DI void phase_gemm1(const Params& p, int layer) {
  pg8::Gemm g{(const bf16_t*)(p.ws + WS_HC), (const bf16_t*)(p.ws + WS_WINT), MTOK, NPW, DM};
  pg8::StaticOrder S; S.init(MTOK, NPW, gridDim.x, blockIdx.x);
  Epi1 E{(bf16_t*)(p.ws + WS_P)};
  pg8::gemm_phase<Epi1, pg8::StaticOrder, false>((PG8_LAS unsigned char*)smem, g, S, E, nullptr);
}
DI void phase_gates(const Params& p) {
  const int tid = opaque_tid(), wid = __builtin_amdgcn_readfirstlane(tid >> 6), lane = tid & 63, fr = lane & 15, fq = lane >> 4;
  const bf16_t* H = (const bf16_t*)(p.ws + WS_HC); const bf16_t* WG = (const bf16_t*)(p.ws + WS_WG); float* GT = (float*)(p.ws + WS_GT);
  f32x4* red = (f32x4*)smem;
  for (int rb = blockIdx.x; rb < MTOK / 64; rb += gridDim.x) {
    __syncthreads();
    f32x4 acc[4];
#pragma unroll
    for (int m = 0; m < 4; ++m) acc[m] = (f32x4){0.f, 0.f, 0.f, 0.f};
#pragma unroll
    for (int ks = 0; ks < 8; ++ks) { const int k0 = wid * 256 + ks * 32 + fq * 8;
      const bf16x8 bw = *(const bf16x8*)(WG + fr * DM + k0);
#pragma unroll
      for (int m = 0; m < 4; ++m) { const bf16x8 a = *(const bf16x8*)(H + (size_t)(rb * 64 + m * 16 + fr) * DM + k0);
        acc[m] = __builtin_amdgcn_mfma_f32_16x16x32_bf16(a, bw, acc[m], 0, 0, 0); } }
#pragma unroll
    for (int m = 0; m < 4; ++m) red[(wid * 4 + m) * 64 + lane] = acc[m];
    __syncthreads();
    if (tid < 256) { const int m = tid >> 6, ln = tid & 63; f32x4 sacc = red[m * 64 + ln];
#pragma unroll
      for (int w = 1; w < 8; ++w) sacc += red[(w * 4 + m) * 64 + ln];
      float* g = GT + (size_t)(rb * 64 + m * 16 + (ln >> 4) * 4) * 16 + (ln & 15);
      g[0] = sacc[0]; g[16] = sacc[1]; g[32] = sacc[2]; g[48] = sacc[3]; }
  }
}
DI void phase_gemm2(const Params& p, int layer) {
  pg8::Gemm g{(const bf16_t*)(p.ws + WS_HC), (const bf16_t*)(p.ws + WS_WOUT), MTOK, DM, DM};
  Epi2 E{(const float*)(p.ws + WS_MOD) + layer * 5 * 6144, (bf16_t*)(p.ws + WS_P)};
  if (layer == 0) { pg8::StaticOrder S; S.init(MTOK, DM, gridDim.x, blockIdx.x); pg8::gemm_phase<Epi2, pg8::StaticOrder, false>((PG8_LAS unsigned char*)smem, g, S, E, nullptr); }
  else { LatentOrder S; S.init(64 * 256, DM, gridDim.x, blockIdx.x); pg8::gemm_phase<Epi2, LatentOrder, false>((PG8_LAS unsigned char*)smem, g, S, E, nullptr); }
}

DI void phase_qknorm(const Params& p, int layer) {
  bf16_t* P = (bf16_t*)(p.ws + WS_P);
  const int l16 = threadIdx.x & 15, d8 = l16 * 8, stride = gridDim.x * 32;
  float invf[8];
#pragma unroll
  for (int e = 0; e < 8; ++e) invf[e] = exp2f(-(float)((d8 & 31) + e) * (13.287712379549449f / 32.f));
  for (int it0 = blockIdx.x * 32 + (threadIdx.x >> 4); it0 < MTOK * 10; it0 += stride * 4) {
    bf16x8 xin[4];
#pragma unroll
    for (int k = 0; k < 4; ++k) { const int it = it0 + k * stride; xin[k] = (bf16x8){0, 0, 0, 0, 0, 0, 0, 0};
      if (it < MTOK * 10) xin[k] = *(const bf16x8*)(P + pidx(it % 10, it / 10) + d8); }
#pragma unroll
    for (int k = 0; k < 4; ++k) { const int it = it0 + k * stride; const bool live = it < MTOK * 10;
      const int row = it / 10, hd = it % 10;
      float y[8]; float ss = 0.f;
#pragma unroll
      for (int e = 0; e < 8; ++e) { y[e] = bf2f((bf16_t)xin[k][e]); ss += y[e] * y[e]; }
      ss += __shfl_xor(ss, 1); ss += __shfl_xor(ss, 2); ss += __shfl_xor(ss, 4); ss += __shfl_xor(ss, 8);
      const float rs = rsqrtf(ss * (1.f / 128.f) + EPS);
      const float* gw = (hd < 8 ? p.q_norm : p.k_norm) + layer * HD + d8;
#pragma unroll
      for (int e = 0; e < 8; ++e) y[e] = y[e] * rs * gw[e];
      const int tin = row % TPB;
      float other[8];
#pragma unroll
      for (int e = 0; e < 8; ++e) other[e] = __shfl_xor(y[e], 4);
      if (tin >= CTX) { const int sq = tin - CTX; const float pos = (float)((d8 >> 6) == 0 ? (sq >> 6) : (sq & 63)); const bool part1 = (d8 >> 5) & 1;
#pragma unroll
        for (int e = 0; e < 8; ++e) { float sn, cs; __sincosf(pos * invf[e], &sn, &cs);
          y[e] = part1 ? (y[e] * cs + other[e] * sn) : (y[e] * cs - other[e] * sn); } }
      if (live) { u32x4 w = {pk2(y[0], y[1]), pk2(y[2], y[3]), pk2(y[4], y[5]), pk2(y[6], y[7])};
        *(u32x4*)(P + pidx(hd, row) + d8) = w; } }
  }
}

constexpr int KVBLK = 64;
constexpr float SCALE = 0.088388347648318440f;
constexpr float THR = 8.f;
constexpr size_t SHM_V = KVBLK * HD * 2, SHM_K = KVBLK * HD * 2;
#define KSWZ(row, colB) ((row) * 256 + ((colB) ^ (((row) & 7) << 4)))
#define SBAR() __builtin_amdgcn_sched_barrier(0)
DI unsigned cvtpk(float lo, float hi) { unsigned r; asm volatile("v_cvt_pk_bf16_f32 %0, %1, %2" : "=v"(r) : "v"(lo), "v"(hi)); return r; }

DI void partialSM(f32x16& p0, f32x16& p1, float& m_reg, float& mn, float& alpha) {
  constexpr float C = SCALE * 1.4426950408889634f;
  float pmax = p0[0];
#pragma unroll
  for (int r = 1; r < 16; ++r) pmax = fmaxf(pmax, p0[r]);
#pragma unroll
  for (int r = 0; r < 16; ++r) pmax = fmaxf(pmax, p1[r]);
  { auto rr = __builtin_amdgcn_permlane32_swap(__float_as_uint(pmax), __float_as_uint(pmax), false, false);
    pmax = fmaxf(__uint_as_float(rr[0]), __uint_as_float(rr[1])); }
  if (__builtin_expect(__all(pmax - m_reg <= THR / SCALE), 1)) { mn = m_reg; alpha = 1.f; }
  else { mn = fmaxf(m_reg, pmax); alpha = __builtin_amdgcn_exp2f((m_reg - mn) * C); m_reg = mn; }
  float mnC = -mn * C;
#pragma unroll
  for (int r = 0; r < 16; ++r) p0[r] = fmaf(p0[r], C, mnC);
#pragma unroll
  for (int r = 0; r < 16; ++r) p1[r] = fmaf(p1[r], C, mnC);
#pragma unroll
  for (int r = 0; r < 16; ++r) p0[r] = __builtin_amdgcn_exp2f(p0[r]);
}
DI void finishSM(f32x16& p0, f32x16& p1, float alpha, float& l_reg, bf16x8& pa0, bf16x8& pa1, bf16x8& pa2, bf16x8& pa3) {
#pragma unroll
  for (int r = 0; r < 16; ++r) p1[r] = __builtin_amdgcn_exp2f(p1[r]);
  float ps = 0;
#pragma unroll
  for (int r = 0; r < 16; ++r) ps += p0[r];
#pragma unroll
  for (int r = 0; r < 16; ++r) ps += p1[r];
  { auto rr = __builtin_amdgcn_permlane32_swap(__float_as_uint(ps), __float_as_uint(ps), false, false);
    ps = __uint_as_float(rr[0]) + __uint_as_float(rr[1]); }
  l_reg = l_reg * alpha + ps;
#define PK4(P, BASE, OUT) do { unsigned a0 = cvtpk(P[BASE + 0], P[BASE + 1]), a1 = cvtpk(P[BASE + 2], P[BASE + 3]);   \
    unsigned b0 = cvtpk(P[BASE + 4], P[BASE + 5]), b1 = cvtpk(P[BASE + 6], P[BASE + 7]);                              \
    auto r0 = __builtin_amdgcn_permlane32_swap(a0, b0, false, false); auto r1 = __builtin_amdgcn_permlane32_swap(a1, b1, false, false); \
    u32x4 w = {r0[0], r1[0], r0[1], r1[1]}; OUT = *reinterpret_cast<bf16x8*>(&w); } while (0)
  PK4(p0, 0, pa0); PK4(p0, 8, pa1); PK4(p1, 0, pa2); PK4(p1, 8, pa3);
#undef PK4
}
DI void qkt(f32x16& p0, f32x16& p1, const char* Ks, const bf16x8* qr, int r32, int hi) {
  p0 = f32x16{}; p1 = f32x16{};
#pragma unroll
  for (int d0 = 0; d0 < 8; ++d0) { int cb = (d0 * 16 + hi * 8) * 2;
    bf16x8 b0 = *reinterpret_cast<const bf16x8*>(Ks + KSWZ(r32, cb));
    bf16x8 b1 = *reinterpret_cast<const bf16x8*>(Ks + KSWZ(32 + r32, cb));
    p0 = __builtin_amdgcn_mfma_f32_32x32x16_bf16(b0, qr[d0], p0, 0, 0, 0);
    p1 = __builtin_amdgcn_mfma_f32_32x32x16_bf16(b1, qr[d0], p1, 0, 0, 0); }
}
DI int v_st(int k, int c) { const int kk = (k & ~0xC) | ((k & 4) << 1) | ((k & 8) >> 1); return ((kk >> 3) * 4 + (c >> 5)) * 512 + ((kk & 7) * 32 + (c & 31)) * 2; }
DI int v_rd_base(int lane) { return ((lane & 3) << 3) | (((lane >> 2) & 3) << 6) | (((lane >> 4) & 1) << 5) | (((lane >> 5) & 1) << 8); }
constexpr int v_rd_off(int d0, int ks, int half) { return d0 * 512 + ks * 4096 + half * 2048; }
template <int OFF> DI s16x4 tr_read(int vb) {
  s16x4 r; asm volatile("ds_read_b64_tr_b16 %0, %1 offset:%2" : "=&v"(r) : "v"(vb), "i"(OFF) : "memory"); return r;
}
template <int D0> DI void pv_one(f32x16& od, int vb, bf16x8 pa0, bf16x8 pa1, bf16x8 pa2, bf16x8 pa3) {
  const s16x4 l0 = tr_read<v_rd_off(D0, 0, 0)>(vb), h0 = tr_read<v_rd_off(D0, 0, 1)>(vb), l1 = tr_read<v_rd_off(D0, 1, 0)>(vb), h1 = tr_read<v_rd_off(D0, 1, 1)>(vb);
  const s16x4 l2 = tr_read<v_rd_off(D0, 2, 0)>(vb), h2 = tr_read<v_rd_off(D0, 2, 1)>(vb), l3 = tr_read<v_rd_off(D0, 3, 0)>(vb), h3 = tr_read<v_rd_off(D0, 3, 1)>(vb);
  asm volatile("s_waitcnt lgkmcnt(0)" ::: "memory"); SBAR();
#define PKV(L, H) (bf16x8){L[0], L[1], L[2], L[3], H[0], H[1], H[2], H[3]}
  od = __builtin_amdgcn_mfma_f32_32x32x16_bf16(pa0, PKV(l0, h0), od, 0, 0, 0);
  od = __builtin_amdgcn_mfma_f32_32x32x16_bf16(pa1, PKV(l1, h1), od, 0, 0, 0);
  od = __builtin_amdgcn_mfma_f32_32x32x16_bf16(pa2, PKV(l2, h2), od, 0, 0, 0);
  od = __builtin_amdgcn_mfma_f32_32x32x16_bf16(pa3, PKV(l3, h3), od, 0, 0, 0);
#undef PKV
}
DI void pv_d0(f32x16* o, int vb, bf16x8 pa0, bf16x8 pa1, bf16x8 pa2, bf16x8 pa3) {
  pv_one<0>(o[0], vb, pa0, pa1, pa2, pa3); pv_one<1>(o[1], vb, pa0, pa1, pa2, pa3); pv_one<2>(o[2], vb, pa0, pa1, pa2, pa3); pv_one<3>(o[3], vb, pa0, pa1, pa2, pa3);
}

DI void na_apply(f32x16& p0, f32x16& p1, int rk, int rq, int cq, const float* rpb_h, int hi) {
  const int r0 = min(max(rq - 4, 0), 56), c0 = min(max(cq - 8, 0), 48);
  const bool rowok = rk >= r0 && rk < r0 + 8;
  const float* bp = rpb_h + (rk - rq + 7) * 31 + 15 - cq;
#pragma unroll
  for (int r = 0; r < 16; ++r) { const int ck = crow(r, hi); const bool ok = rowok && ck >= c0 && ck < c0 + 16;
    float bias = 0.f; if (ok) bias = bp[ck]; p0[r] = ok ? p0[r] + bias * (1.f / SCALE) : -1e30f; }
#pragma unroll
  for (int r = 0; r < 16; ++r) { const int ck = 32 + crow(r, hi); const bool ok = rowok && ck >= c0 && ck < c0 + 16;
    float bias = 0.f; if (ok) bias = bp[ck]; p1[r] = ok ? p1[r] + bias * (1.f / SCALE) : -1e30f; }
}

template <bool NA, int SD>
DI void attn_body(const bf16_t* __restrict__ Qb, const bf16_t* __restrict__ Kb, const bf16_t* __restrict__ Vb, const bf16_t* __restrict__ Zb,
                  bf16_t* __restrict__ Ob, int NT, int rlo, int rq0, const float* rpb_h, float oscale = 1.f) {
  char* lds = smem;
  const int tid = opaque_tid(), wid = __builtin_amdgcn_readfirstlane(tid >> 6), lane = tid & 63, r32 = lane & 31, hi = lane >> 5;
  char* V_lds = lds; char* K_lds = lds + 2 * SHM_V;
  float* wsx = (float*)(lds + 2 * SHM_V + 2 * SHM_K) + wid * 64; float* li_l = wsx; float* al_l = wsx + 32;
  const int toff = NA ? 0 : rq0;
  float m_reg = -1e30f, l_reg = 0; f32x16 o[4] = {}; bf16x8 qr[8];
  const bf16_t* Qw = Qb + (size_t)(wid * 32 + r32) * HD + hi * 8;
#pragma unroll
  for (int d0 = 0; d0 < 8; ++d0) qr[d0] = *(const bf16x8*)(Qw + d0 * 16);
  const int sr = tid >> 4, sc = (tid & 15) * 8, vst0 = v_st(sr, sc), vst1 = v_st(32 + sr, sc);
  const int vb0 = (int)(uintptr_t)V_lds + v_rd_base(lane);
  const int rq = rq0 + (wid >> 1), cq = (wid & 1) * 32 + r32;
  struct { bf16x8 vs0, vs1, ks0, ks1; } sr_[SD];
#define TROW(j) (NA ? ((j) < 4 ? (j) * 64 : CTX + (rlo + (j) - 4) * 64) : (((j) + toff) % NT) * 64)
#define SLOAD(i, j) do { const size_t k0_ = (size_t)TROW(j); sr_[i].vs0 = *(const bf16x8*)(&Vb[(k0_ + sr) * HD + sc]); sr_[i].vs1 = *(const bf16x8*)(&Vb[(k0_ + 32 + sr) * HD + sc]); \
    sr_[i].ks0 = *(const bf16x8*)(&Kb[(k0_ + sr) * HD + sc]); sr_[i].ks1 = *(const bf16x8*)(&Kb[(k0_ + 32 + sr) * HD + sc]); } while (0)
#define SWRITE(b, i) do { *(bf16x8*)(V_lds + (b) * SHM_V + vst0) = sr_[i].vs0;          \
    *(bf16x8*)(V_lds + (b) * SHM_V + vst1) = sr_[i].vs1; int kc = sc * 2;               \
    *(bf16x8*)(K_lds + (b) * SHM_K + KSWZ(sr, kc)) = sr_[i].ks0;                       \
    *(bf16x8*)(K_lds + (b) * SHM_K + KSWZ(32 + sr, kc)) = sr_[i].ks1; } while (0)
#define SWAIT() do { if constexpr (SD == 2) asm volatile("s_waitcnt vmcnt(4)" ::: "memory"); else asm volatile("s_waitcnt vmcnt(0)" ::: "memory"); } while (0)
#define RESC(a) do { if (__any((a) < 1.f)) { if (hi == 0) al_l[r32] = (a); asm volatile("s_waitcnt lgkmcnt(0)" ::: "memory"); \
    for (int d = 0; d < 4; ++d) for (int r = 0; r < 16; ++r) o[d][r] *= al_l[crow(r, hi)]; } } while (0)
#define NAMASK(PA, PB, j) do { if (NA && (j) >= 4) na_apply(PA, PB, rlo + (j) - 4, rq, cq, rpb_h, hi); } while (0)
  f32x16 pA0, pA1, pB0, pB1; float mnA, mnB, alA, alB; bf16x8 pa0, pa1, pa2, pa3;
  constexpr int SE = 0, SO = SD - 1;
  SLOAD(SE, 0); asm volatile("s_waitcnt vmcnt(0)" ::: "memory"); SWRITE(0, SE); __syncthreads();
  qkt(pA0, pA1, K_lds, qr, r32, hi); NAMASK(pA0, pA1, 0); partialSM(pA0, pA1, m_reg, mnA, alA);
  SLOAD(SO, 1); if constexpr (SD == 2) { if (2 < NT) SLOAD(SE, 2); }
  SWAIT(); SWRITE(1, SO); __syncthreads();
  for (int j = 1; j + 1 < NT; j += 2) {
    SBAR(); qkt(pB0, pB1, K_lds + SHM_K, qr, r32, hi); NAMASK(pB0, pB1, j);
    finishSM(pA0, pA1, alA, l_reg, pa0, pa1, pa2, pa3); SBAR();
    SLOAD(SO, j + SD); SBAR();
    pv_d0(o, vb0, pa0, pa1, pa2, pa3); partialSM(pB0, pB1, m_reg, mnB, alB);
    __syncthreads(); SWAIT(); SWRITE(0, SE);
    RESC(alB); __syncthreads();
    SBAR(); qkt(pA0, pA1, K_lds, qr, r32, hi); NAMASK(pA0, pA1, j + 1);
    finishSM(pB0, pB1, alB, l_reg, pa0, pa1, pa2, pa3); SBAR();
    if (SD == 1 || j + 3 < NT) SLOAD(SE, j + 1 + SD); SBAR();
    pv_d0(o, vb0 + (int)SHM_V, pa0, pa1, pa2, pa3); partialSM(pA0, pA1, m_reg, mnA, alA);
    __syncthreads(); SWAIT(); SWRITE(1, SO);
    RESC(alA); __syncthreads();
  }
  SBAR(); qkt(pB0, pB1, K_lds + SHM_K, qr, r32, hi); NAMASK(pB0, pB1, NT - 1);
  finishSM(pA0, pA1, alA, l_reg, pa0, pa1, pa2, pa3); SBAR();
  pv_d0(o, vb0, pa0, pa1, pa2, pa3); partialSM(pB0, pB1, m_reg, mnB, alB);
  __syncthreads(); RESC(alB);
  finishSM(pB0, pB1, alB, l_reg, pa0, pa1, pa2, pa3); SBAR();
  pv_d0(o, vb0 + (int)SHM_V, pa0, pa1, pa2, pa3);
  if (hi == 0) li_l[r32] = l_reg; asm volatile("s_waitcnt lgkmcnt(0)" ::: "memory");
  float rli[16];
#pragma unroll
  for (int r = 0; r < 16; ++r) rli[r] = __builtin_amdgcn_rcpf(li_l[crow(r, hi)]);
  bf16_t* Ow = Ob + (size_t)(wid * 32) * DM; const bf16_t* Zw = Zb + (size_t)(wid * 32) * HD;
#pragma unroll
  for (int r = 0; r < 16; ++r) { const int orow = crow(r, hi);
#pragma unroll
    for (int d0 = 0; d0 < 4; ++d0) { const float gz = bf2f(Zw[(size_t)orow * HD + d0 * 32 + r32]);
      Ow[(size_t)orow * DM + d0 * 32 + r32] = f2bf(o[d0][r] * rli[r] * gz * oscale); } }
#undef SLOAD
#undef SWRITE
#undef SWAIT
#undef RESC
#undef NAMASK
#undef TROW
}

constexpr int PL_QS = 0, PL_KS = 17408, PL_VT = 34816, PL_KTT = 53248, PL_LM = 71680, PL_TU = 106496, PL_TW = 124928, PL_G = 143360;
DI void dn_prep(const Params& p, int layer, int task) {
  const int tid = opaque_tid(), wid = tid >> 6, lane = tid & 63, fr = lane & 15, fq = lane >> 4;
  const int bh = task / NCH, ch = task % NCH, b = bh >> 2, h = bh & 3;
  const size_t tok0 = (size_t)b * TPB + ch * 64;
  const bool has_left = !(ch == 0 || ch == 4), has_right = !(ch == 3 || ch == NCH - 1);
  const bf16_t* P = (const bf16_t*)(p.ws + WS_P); const float* GT = (const float*)(p.ws + WS_GT);
  bf16_t* qs = (bf16_t*)(smem + PL_QS); bf16_t* ks = (bf16_t*)(smem + PL_KS); bf16_t* vT = (bf16_t*)(smem + PL_VT); bf16_t* kT = (bf16_t*)(smem + PL_KTT);
  float* Lm = (float*)(smem + PL_LM); bf16_t* Tu = (bf16_t*)(smem + PL_TU); bf16_t* Tw = (bf16_t*)(smem + PL_TW);
  float* gbeta = (float*)(smem + PL_G); float* ggc = gbeta + 128; float* geg = gbeta + 256;
  bf16_t* QN = (bf16_t*)(p.ws + WS_QN) + (size_t)(bh * NCH + ch) * 64 * 128;
  bf16_t* KTg = (bf16_t*)(p.ws + WS_KT) + (size_t)(bh * NCH + ch) * 128 * 64;

  float* ssbuf = (float*)(smem + 144896);
  if (tid < 128) ssbuf[tid] = 0.f;
  __syncthreads();
  if (wid < 2) { const int dir = wid;
    const float* gr = GT + (tok0 + lane) * 16 + dir * 8;
    const float beta = 1.f / (1.f + __expf(-gr[h]));
    const float a = gr[4 + h] + p.dt_bias[layer * 8 + dir * 4 + h];
    const float sp = a > 20.f ? a : log1pf(__expf(a));
    float x = -__expf(p.a_log[layer * 8 + dir * 4 + h]) * sp;
    if (dir == 0) { for (int o = 1; o < 64; o <<= 1) { float t = __shfl_up(x, o); if (lane >= o) x += t; } }
    else { for (int o = 1; o < 64; o <<= 1) { float t = __shfl_down(x, o); if (lane + o < 64) x += t; } }
    const float glast = __shfl(x, dir == 0 ? 63 : 0);
    const float eg = __expf(x);
    gbeta[dir * 64 + lane] = beta; ggc[dir * 64 + lane] = x; geg[dir * 64 + lane] = eg;
    float* GC = (float*)(p.ws + WS_GC) + (size_t)((bh * 2 + dir) * NCH + ch) * 136;
    GC[lane] = eg; GC[64 + lane] = __expf(glast - x); if (lane == 0) GC[128] = __expf(glast);
  }
  SBAR();
  bf16_t* raw = (bf16_t*)(smem + PL_LM);
  { bf16x8 rv[7];
#pragma unroll
    for (int i = 0; i < 7; ++i) { const int idx = tid + i * 512, rr = idx >> 4, ck = idx & 15, which = rr / 66, lr = rr % 66;
      rv[i] = (bf16x8){0, 0, 0, 0, 0, 0, 0, 0};
      if (idx < 3 * 66 * 16 && (lr > 0 || has_left) && (lr < 65 || has_right)) rv[i] = *(const bf16x8*)(P + pidx(36 + which * 4 + h, tok0 + lr - 1) + ck * 8); }
#pragma unroll
    for (int i = 0; i < 7; ++i) { const int idx = tid + i * 512, rr = idx >> 4, ck = idx & 15;
      if (idx < 3 * 66 * 16) *(bf16x8*)(raw + rr * 136 + ck * 8) = rv[i]; } }
  __syncthreads();
  float yv[6][8];
  const int wu = __builtin_amdgcn_readfirstlane(wid);
  { const int c = lane;
#pragma unroll
    for (int k = 0; k < 6; ++k) { const int chk = wu * 6 + k, which = chk >> 4, d8 = (chk & 15) * 8;
      const bf16_t* rp = raw + (which * 66 + c) * 136 + d8;
      const bf16x8 xm = *(const bf16x8*)rp, x0 = *(const bf16x8*)(rp + 136), xp = *(const bf16x8*)(rp + 272);
      const float* cw = p.conv_w + (size_t)layer * 3 * 1536 + which * 512 + h * 128 + d8;
      float ss = 0.f;
#pragma unroll
      for (int e = 0; e < 8; ++e) { float v = cw[e] * bf2f((bf16_t)xm[e]) + cw[1536 + e] * bf2f((bf16_t)x0[e]) + cw[3072 + e] * bf2f((bf16_t)xp[e]);
        v = silu_f(v); yv[k][e] = v; ss += v * v; }
      if (which < 2) atomicAdd(&ssbuf[which * 64 + c], ss); } }
  __syncthreads();
  { const int c = lane, cp = perm_k(c);
#pragma unroll
    for (int k = 0; k < 6; ++k) { const int chk = wu * 6 + k, which = chk >> 4, d8 = (chk & 15) * 8;
      float rn = 1.f; if (which < 2) rn = rsqrtf(ssbuf[which * 64 + c] + EPS) * (which == 0 ? 0.088388347648318440f : 1.f);
      float y[8];
#pragma unroll
      for (int e = 0; e < 8; ++e) y[e] = yv[k][e] * rn;
      if (which == 0) { u32x4 w = {pk2(y[0], y[1]), pk2(y[2], y[3]), pk2(y[4], y[5]), pk2(y[6], y[7])};
        *(u32x4*)(qs + c * 136 + d8) = w;
        bf16_t* qd = QN + c * 128; const int c0 = (d8 >> 4) * 2, sw = c & 15, wi = (d8 & 8) ? 4 : 0;
        *(u32x2*)(qd + ((c0 ^ sw) << 3) + wi) = (u32x2){w.x, w.y}; *(u32x2*)(qd + (((c0 + 1) ^ sw) << 3) + wi) = (u32x2){w.z, w.w};
      } else if (which == 1) { u32x4 w = {pk2(y[0], y[1]), pk2(y[2], y[3]), pk2(y[4], y[5]), pk2(y[6], y[7])};
        *(u32x4*)(ks + c * 136 + d8) = w;
#pragma unroll
        for (int e = 0; e < 8; ++e) { const bf16_t kv = f2bf(y[e]); const int d = d8 + e; kT[d * 72 + c] = kv; KTg[d * 64 + ((((cp >> 3) ^ ((d >> 1) & 7)) << 3) | (cp & 7))] = kv; }
      } else {
#pragma unroll
        for (int e = 0; e < 8; ++e) vT[(d8 + e) * 72 + c] = f2bf(y[e]);
      } } }
  __syncthreads();
  SBAR();
  { const int sel = wid >> 2, mi = wid & 3;
    const bf16_t* Ar = (sel == 0 ? ks : qs) + (mi * 16 + fr) * 136 + fq * 8;
    f32x4 acc[4];
#pragma unroll
    for (int n = 0; n < 4; ++n) acc[n] = (f32x4){0.f, 0.f, 0.f, 0.f};
#pragma unroll
    for (int kk = 0; kk < 4; ++kk) { const bf16x8 a = *(const bf16x8*)(Ar + kk * 32);
#pragma unroll
      for (int n = 0; n < 4; ++n) { const bf16x8 bb = *(const bf16x8*)(ks + (n * 16 + fr) * 136 + kk * 32 + fq * 8);
        acc[n] = __builtin_amdgcn_mfma_f32_16x16x32_bf16(a, bb, acc[n], 0, 0, 0); } }
    bf16_t* QKg = (bf16_t*)(p.ws + WS_QK);
#pragma unroll
    for (int n = 0; n < 4; ++n)
#pragma unroll
      for (int j = 0; j < 4; ++j) { const int i = mi * 16 + fq * 4 + j, jj = n * 16 + fr; const float val = acc[n][j];
#pragma unroll
        for (int dir = 0; dir < 2; ++dir) { const float e = __expf(fminf(ggc[dir * 64 + i] - ggc[dir * 64 + jj], 0.f));
          if (sel == 0) { const bool ok = dir == 0 ? (i > jj) : (i < jj); const float lv = ok ? gbeta[dir * 64 + i] * val * e : 0.f;
            const int i2 = dir == 0 ? i : 63 - i, j2 = dir == 0 ? jj : 63 - jj; Lm[(dir * 64 + i2) * 68 + j2] = lv; }
          else { const bool ok = dir == 0 ? (i >= jj) : (i <= jj);
            const int pj = perm_k(jj);
            QKg[((size_t)((bh * 2 + dir) * NCH + ch) * 64 + i) * 64 + ((((pj >> 3) ^ ((i >> 1) & 7)) << 3) | (pj & 7))] = f2bf(ok ? val * e : 0.f); } } }
  }
  __syncthreads();
  SBAR();
  if (wid < 2) { const int dir = wid; const float* Lr = Lm + dir * 64 * 68;
    float t[64];
#pragma unroll
    for (int i = 0; i < 64; ++i) t[i] = 0.f;
#pragma unroll
    for (int i = 0; i < 64; ++i) { float a0 = (i == lane) ? 1.f : 0.f, a1 = 0.f, a2 = 0.f, a3 = 0.f;
#pragma unroll
      for (int j4 = 0; j4 < (i + 3) / 4; ++j4) { const f32x4 l = *(const f32x4*)(Lr + i * 68 + j4 * 4);
        a0 -= l[0] * t[j4 * 4]; a1 -= l[1] * t[j4 * 4 + 1]; a2 -= l[2] * t[j4 * 4 + 2]; a3 -= l[3] * t[j4 * 4 + 3]; }
      const float a = (a0 + a1) + (a2 + a3);
      t[i] = a; Lm[(dir * 64 + i) * 68 + lane] = a; }
  }
  __syncthreads();
  SBAR();
#pragma unroll 1
  for (int i = 0; i < 16; ++i) { const int idx = tid + i * 512, dir = idx >> 12, i2 = (idx >> 6) & 63, j2 = idx & 63;
    const float tv = Lm[(dir * 64 + i2) * 68 + j2];
    const int ir = dir == 0 ? i2 : 63 - i2, jc = dir == 0 ? j2 : 63 - j2;
    const float bj = gbeta[dir * 64 + jc];
    Tu[(dir * 64 + ir) * 72 + jc] = f2bf(tv * bj); Tw[(dir * 64 + ir) * 72 + jc] = f2bf(tv * bj * geg[dir * 64 + jc]); }
  __syncthreads();
  SBAR();
  { const int mat = wid >> 1, nh = wid & 1, dir = mat & 1, isw = mat >> 1;
    const bf16_t* Am = (isw ? Tw : Tu) + dir * 64 * 72; const bf16_t* Bm = isw ? kT : vT;
    f32x4 acc[4][4];
#pragma unroll
    for (int m = 0; m < 4; ++m)
#pragma unroll
      for (int n = 0; n < 4; ++n) acc[m][n] = (f32x4){0.f, 0.f, 0.f, 0.f};
#pragma unroll
    for (int kk = 0; kk < 2; ++kk) { bf16x8 a[4], bb[4];
#pragma unroll
      for (int m = 0; m < 4; ++m) a[m] = *(const bf16x8*)(Am + (m * 16 + fr) * 72 + kk * 32 + fq * 8);
#pragma unroll
      for (int n = 0; n < 4; ++n) bb[n] = *(const bf16x8*)(Bm + ((nh * 4 + n) * 16 + fr) * 72 + kk * 32 + fq * 8);
#pragma unroll
      for (int m = 0; m < 4; ++m)
#pragma unroll
        for (int n = 0; n < 4; ++n) acc[m][n] = __builtin_amdgcn_mfma_f32_16x16x32_bf16(a[m], bb[n], acc[m][n], 0, 0, 0); }
    const size_t cb = (size_t)((bh * 2 + dir) * NCH + ch);
    bf16_t* Ul = (bf16_t*)(p.ws + WS_U) + cb * 64 * 128 + nh * 4096 + fr * 16 + (fq & 1) * 512 + (fq >> 1) * 4;
    bf16_t* Wl = (bf16_t*)(p.ws + WS_W) + cb * 64 * 128 + fq * 512; const int wp = invperm16(fr);
    if (isw) {
#pragma unroll
      for (int m = 0; m < 4; ++m)
#pragma unroll
        for (int n = 0; n < 4; ++n)
#pragma unroll
          for (int j = 0; j < 4; ++j) Wl[(m * 16 + j) * 128 + (((((nh * 4 + n) * 2 + (wp >> 3)) ^ (fq * 4 + j)) << 3) | (wp & 7))] = f2bf(-acc[m][n][j]);
    } else {
#pragma unroll
      for (int m = 0; m < 4; ++m)
#pragma unroll
        for (int n = 0; n < 4; ++n) { u32x2 w = {pk2(acc[m][n][0], acc[m][n][1]), pk2(acc[m][n][2], acc[m][n][3])};
          *(u32x2*)(Ul + (n >> 1) * 2048 + (m >> 1) * 1024 + (n & 1) * 256 + 8 * (m & 1)) = w; }
    }
  }
  __syncthreads();
}

constexpr int SC_W = 0, SC_QN = 16384, SC_QK = 32768, SC_KT = 40960, SC_U = 57344, SC_GC = 73728, SC_BUF = 74752;
DI bf16x8 pack8(const f32x16& x, int s) {
  u32x4 w = {pk2(x[8 * s], x[8 * s + 1]), pk2(x[8 * s + 2], x[8 * s + 3]), pk2(x[8 * s + 4], x[8 * s + 5]), pk2(x[8 * s + 6], x[8 * s + 7])};
  return __builtin_bit_cast(bf16x8, w);
}
#define MFMA32(a, b, c) __builtin_amdgcn_mfma_f32_32x32x16_bf16((a), (b), (c), 0, 0, 0)
DI int scan_chunk(int dir, int step) { return dir == 0 ? step : (step < 4 ? 3 - step : 71 - step); }
DI void scan_issue(const Params& p, int bh, int dir, int step, int buf, int ltid) {
  const int ch = scan_chunk(dir, step);
  const size_t cb = (size_t)((bh * 2 + dir) * NCH + ch), cq = (size_t)(bh * NCH + ch);
  const char* Wg = p.ws + WS_W + cb * 16384; const char* Ug = p.ws + WS_U + cb * 16384; const char* QKg = p.ws + WS_QK + cb * 8192;
  const char* GCg = p.ws + WS_GC + cb * 544; const char* QNg = p.ws + WS_QN + cq * 16384; const char* KTg = p.ws + WS_KT + cq * 16384;
  char* dst = smem + buf * SC_BUF; const int o = ltid * 16;
#pragma unroll
  for (int i = 0; i < 4; ++i) {
    __builtin_amdgcn_global_load_lds((const unsigned*)(Wg + o + i * 4096), (unsigned*)(dst + SC_W + o + i * 4096), 16, 0, 0);
    __builtin_amdgcn_global_load_lds((const unsigned*)(QNg + o + i * 4096), (unsigned*)(dst + SC_QN + o + i * 4096), 16, 0, 0);
    __builtin_amdgcn_global_load_lds((const unsigned*)(KTg + o + i * 4096), (unsigned*)(dst + SC_KT + o + i * 4096), 16, 0, 0);
    __builtin_amdgcn_global_load_lds((const unsigned*)(Ug + o + i * 4096), (unsigned*)(dst + SC_U + o + i * 4096), 16, 0, 0); }
#pragma unroll
  for (int i = 0; i < 2; ++i) __builtin_amdgcn_global_load_lds((const unsigned*)(QKg + o + i * 4096), (unsigned*)(dst + SC_QK + o + i * 4096), 16, 0, 0);
  if (ltid < 34) __builtin_amdgcn_global_load_lds((const unsigned*)(GCg + o), (unsigned*)(dst + SC_GC + o), 16, 0, 0);
}
DI void dn_scan_block(const Params& p, int bh, int dir) {
  const int tid = opaque_tid(), wid = __builtin_amdgcn_readfirstlane(tid >> 6), lane = tid & 63, r = lane & 31, hh = lane >> 5;
  const int b = bh >> 2, h = bh & 3, eb = wid & 3;
  const bool loader = wid >= 4;
  f32x16 S[4];
#pragma unroll
  for (int d = 0; d < 4; ++d) S[d] = f32x16{};
  bf16_t* Og = (bf16_t*)(p.ws + (dir == 0 ? WS_OF : WS_OB)) + (size_t)b * TPB * 512 + h * 128 + eb * 32 + r;
  __syncthreads();
  if (loader) { scan_issue(p, bh, dir, 0, 0, tid - 256); asm volatile("s_waitcnt vmcnt(0)" ::: "memory"); }
  __builtin_amdgcn_s_barrier(); asm volatile("" ::: "memory");
#pragma unroll 1
  for (int step = 0; step < NCH; ++step) {
    if (loader) {
      if (step + 1 < NCH) scan_issue(p, bh, dir, step + 1, (step + 1) & 1, tid - 256);
      asm volatile("s_waitcnt vmcnt(0)" ::: "memory");
    } else {
      const char* B = smem + (step & 1) * SC_BUF;
      const int ch = scan_chunk(dir, step);
      bf16x8 Sp[8];
#pragma unroll
      for (int d = 0; d < 4; ++d) { Sp[2 * d] = pack8(S[d], 0); Sp[2 * d + 1] = pack8(S[d], 1); }
      f32x16 VN[2], O[2];
#pragma unroll
      for (int ct = 0; ct < 2; ++ct) { const char* up = B + SC_U + ((eb * 2 + ct) * 64 + lane) * 32;
        const bf16x8 u0 = *(const bf16x8*)up, u1 = *(const bf16x8*)(up + 16);
#pragma unroll
        for (int i = 0; i < 8; ++i) { VN[ct][i] = bf2f((bf16_t)u0[i]); VN[ct][8 + i] = bf2f((bf16_t)u1[i]); }
        O[ct] = f32x16{}; }
#pragma unroll
      for (int ct = 0; ct < 2; ++ct) { const int R = ct * 32 + r;
#pragma unroll
        for (int ks = 0; ks < 8; ++ks) { const int co = (((ks * 2 + hh) ^ (R & 15)) << 4);
          const bf16x8 aw = *(const bf16x8*)(B + SC_W + R * 256 + co); VN[ct] = MFMA32(aw, Sp[ks], VN[ct]);
          const bf16x8 aq = *(const bf16x8*)(B + SC_QN + R * 256 + co); O[ct] = MFMA32(aq, Sp[ks], O[ct]); if (ks == 3 || ks == 7) SBAR(); } }
      const float* GC = (const float*)(B + SC_GC);
#pragma unroll
      for (int ct = 0; ct < 2; ++ct)
#pragma unroll
        for (int q4 = 0; q4 < 4; ++q4) { const f32x4 eg = *(const f32x4*)(GC + ct * 32 + 8 * q4 + 4 * hh);
#pragma unroll
          for (int i = 0; i < 4; ++i) O[ct][q4 * 4 + i] *= eg[i]; }
      bf16x8 Vp[4];
#pragma unroll
      for (int ct = 0; ct < 2; ++ct) { Vp[2 * ct] = pack8(VN[ct], 0); Vp[2 * ct + 1] = pack8(VN[ct], 1); }
#pragma unroll
      for (int ct = 0; ct < 2; ++ct) { const int R = ct * 32 + r;
#pragma unroll
        for (int ks = 0; ks < 4; ++ks) { const bf16x8 a = *(const bf16x8*)(B + SC_QK + R * 128 + (((ks * 2 + hh) ^ ((R >> 1) & 7)) << 4)); O[ct] = MFMA32(a, Vp[ks], O[ct]); } SBAR(); }
      { bf16_t* od = Og + (size_t)(ch * 64) * 512;
#pragma unroll
        for (int ct = 0; ct < 2; ++ct)
#pragma unroll
          for (int i = 0; i < 16; ++i) od[(size_t)(ct * 32 + crow(i, hh)) * 512] = f2bf(O[ct][i]); }
#pragma unroll
      for (int ct = 0; ct < 2; ++ct)
#pragma unroll
        for (int q4 = 0; q4 < 4; ++q4) { const f32x4 ek = *(const f32x4*)(GC + 64 + ct * 32 + 8 * q4 + 4 * hh);
#pragma unroll
          for (int i = 0; i < 4; ++i) VN[ct][q4 * 4 + i] *= ek[i]; }
#pragma unroll
      for (int ct = 0; ct < 2; ++ct) { Vp[2 * ct] = pack8(VN[ct], 0); Vp[2 * ct + 1] = pack8(VN[ct], 1); }
      const float egl = GC[128];
#pragma unroll
      for (int d = 0; d < 4; ++d) { const int R = d * 32 + r;
#pragma unroll
        for (int i = 0; i < 16; ++i) S[d][i] *= egl;
#pragma unroll
        for (int ks = 0; ks < 4; ++ks) { const bf16x8 a = *(const bf16x8*)(B + SC_KT + R * 128 + (((ks * 2 + hh) ^ ((R >> 1) & 7)) << 4)); S[d] = MFMA32(a, Vp[ks], S[d]); } SBAR(); }
      asm volatile("s_waitcnt lgkmcnt(0)" ::: "memory");
    }
    __builtin_amdgcn_s_barrier(); asm volatile("" ::: "memory");
  }
}

#ifndef PROBE_DUP
#define PROBE_DUP 0
#endif
DI void run_attn_unit(const Params& p, int layer, int kind, int id) {
  const bf16_t* P = (const bf16_t*)(p.ws + WS_P); bf16_t* CC = (bf16_t*)(p.ws + WS_HC);
  const bf16_t *Qp, *Kp, *Vp, *Zp; bf16_t* Op; int NT = 4, rlo = 0, rq0 = 0; const float* rp = nullptr;
  if (kind == 0) { const int qb = id & 15, h = (id >> 4) & 7, b = id >> 7; const size_t t0 = (size_t)b * TPB, q0 = t0 + CTX + qb * 256;
    Qp = P + pidx(h, q0); Kp = P + pidx(8 + (h >> 2), t0); Vp = P + pidx(10 + (h >> 2), t0); Zp = P + pidx(12 + h, q0);
    Op = CC + q0 * DM + h * 128; NT = TPB / 64; rq0 = ((((h & 3) * 16 + qb) * 4) % 68);
  } else if (kind == 1) { const int qb = id & 15, h = (id >> 4) & 3, b = id >> 6; const size_t t0 = (size_t)b * TPB, q0 = t0 + CTX + qb * 256;
    rq0 = qb * 4; rlo = min(max(rq0 - 4, 0), 52); NT = 16; rp = p.rpb + (size_t)(layer * 4 + h) * 15 * 31;
    Qp = P + pidx(20 + h, q0); Kp = P + pidx(24 + h, t0); Vp = P + pidx(28 + h, t0); Zp = P + pidx(32 + h, q0);
    Op = CC + q0 * DM + 1024 + h * 128;
  } else if (kind == 2) { const int h = id & 7, b = id >> 3; const size_t t0 = (size_t)b * TPB;
    Qp = P + pidx(h, t0); Kp = P + pidx(8 + (h >> 2), t0); Vp = P + pidx(10 + (h >> 2), t0); Zp = P + pidx(12 + h, t0);
    Op = CC + t0 * DM + h * 128;
  } else { const int h = id & 3, b = id >> 2; const size_t t0 = (size_t)b * TPB;
    Qp = P + pidx(20 + h, t0); Kp = P + pidx(24 + h, t0); Vp = P + pidx(28 + h, t0); Zp = P + pidx(32 + h, t0);
    Op = CC + t0 * DM + 1024 + h * 128;
  }
  if (kind == 1) attn_body<true, 1>(Qp, Kp, Vp, Zp, Op, NT, rlo, rq0, rp);
  else attn_body<false, 2>(Qp, Kp, Vp, Zp, Op, NT, 0, rq0, nullptr);
}
constexpr int AX = 288;
DI void phase_x(const Params& p, int layer, int pass = 0) {
  const int tid = threadIdx.x;
  int* ctr = (int*)(p.ws + WS_CTR) + layer * 2 + pass * 4;
  int* s_unit = (int*)(smem + LDS_BYTES - 16);
  const int total = AX + 16 * NCH + 256 + (layer == 0 ? 16 : 0);
  for (;;) {
    __syncthreads();
    if (tid == 0) *s_unit = atomicAdd(ctr, 1);
    __syncthreads();
    const int u = __builtin_amdgcn_readfirstlane(*s_unit);
    if (u >= total) break;
    if (u < AX) run_attn_unit(p, layer, 0, u);
    else if (u < AX + 16 * NCH) dn_prep(p, layer, u - AX);
    else if (u < AX + 16 * NCH + 256) run_attn_unit(p, layer, 1, u - AX - 16 * NCH);
    else run_attn_unit(p, layer, 3, u - AX - 16 * NCH - 256);
  }
}
DI void phase_y(const Params& p, int layer, int pass = 0) {
  const int tid = threadIdx.x;
  if (blockIdx.x < 32) dn_scan_block(p, blockIdx.x >> 1, blockIdx.x & 1);
  int* ctr = (int*)(p.ws + WS_CTR) + layer * 2 + 1 + pass * 4;
  int* s_unit = (int*)(smem + LDS_BYTES - 16);
  const int total = (512 - AX) + (layer == 0 ? 32 : 0);
  for (;;) {
    __syncthreads();
    if (tid == 0) *s_unit = atomicAdd(ctr, 1);
    __syncthreads();
    const int u = __builtin_amdgcn_readfirstlane(*s_unit);
    if (u >= total) break;
    if (u < 512 - AX) run_attn_unit(p, layer, 0, AX + u);
    else run_attn_unit(p, layer, 2, u - (512 - AX));
  }
}

DI void phase_yc(const Params& p, int layer) {
  const bf16_t* OF = (const bf16_t*)(p.ws + WS_OF); const bf16_t* OB = (const bf16_t*)(p.ws + WS_OB);
  const bf16_t* P = (const bf16_t*)(p.ws + WS_P); bf16_t* CC = (bf16_t*)(p.ws + WS_HC);
  const float* on = p.o_norm + layer * HD;
  const int l16 = threadIdx.x & 15, stride = gridDim.x * 32;
  for (int it0 = blockIdx.x * 32 + (threadIdx.x >> 4); it0 < MTOK * 4; it0 += stride * 4) {
    bf16x8 av[4], bv[4], zv[4];
#pragma unroll
    for (int k = 0; k < 4; ++k) { const int it = it0 + k * stride; av[k] = (bf16x8){0, 0, 0, 0, 0, 0, 0, 0}; bv[k] = av[k]; zv[k] = av[k];
      if (it < MTOK * 4 && !(layer == 1 && ((it >> 2) % TPB) < CTX)) { const int tok = it >> 2, h = it & 3; const size_t o = (size_t)tok * 512 + h * 128 + l16 * 8;
        av[k] = *(const bf16x8*)(OF + o); bv[k] = *(const bf16x8*)(OB + o); zv[k] = *(const bf16x8*)(P + pidx(48 + h, tok) + l16 * 8); } }
#pragma unroll
    for (int k = 0; k < 4; ++k) { const int it = it0 + k * stride; const int tok = it >> 2, h = it & 3;
      float y[8]; float ss = 0.f;
#pragma unroll
      for (int e = 0; e < 8; ++e) { y[e] = bf2f((bf16_t)av[k][e]) + bf2f((bf16_t)bv[k][e]); ss += y[e] * y[e]; }
      ss += __shfl_xor(ss, 1); ss += __shfl_xor(ss, 2); ss += __shfl_xor(ss, 4); ss += __shfl_xor(ss, 8);
      const float rs = rsqrtf(ss * (1.f / 128.f) + EPS);
#pragma unroll
      for (int e = 0; e < 8; ++e) y[e] = y[e] * rs * on[l16 * 8 + e] * bf2f((bf16_t)zv[k][e]);
      if (it < MTOK * 4 && !(layer == 1 && (tok % TPB) < CTX)) { u32x4 w = {pk2(y[0], y[1]), pk2(y[2], y[3]), pk2(y[4], y[5]), pk2(y[6], y[7])};
        *(u32x4*)(CC + (size_t)tok * DM + 1536 + h * 128 + l16 * 8) = w; } }
  }
}

#define XB_TMO      128
#define XB_XCNT(j)  (256  + 64 * (j))
#define XB_XSUB(j)  (1280 + 64 * (j))
#define XB_XGEN(j)  (2304 + 64 * (j))
#define XB_TOP      3328
#define XB_TOPGEN   3392
#define XCD_BAR_WORDS 3456
#define XB_SPIN_CAP (1u << 18)
#define LAS __attribute__((address_space(3)))

__device__ __forceinline__ unsigned xb_ld(unsigned* p)              { return __hip_atomic_load(p, __ATOMIC_RELAXED, __HIP_MEMORY_SCOPE_AGENT); }
__device__ __forceinline__ unsigned xb_add(unsigned* p, unsigned v) { return __hip_atomic_fetch_add(p, v, __ATOMIC_RELAXED, __HIP_MEMORY_SCOPE_AGENT); }
__device__ __forceinline__ unsigned xb_xcc_id() { return (unsigned)__builtin_amdgcn_s_getreg((3 << 11) | 20) & 0xFu; }
#define XB_SPIN(cond, bar) do { unsigned _sp = 0; while (cond) { __builtin_amdgcn_s_sleep(1); \
    if ((++_sp & 255u) == 0u) { if (xb_ld(&(bar)[XB_TMO])) break; if (_sp > XB_SPIN_CAP) { atomicAdd(&(bar)[XB_TMO], 1u); break; } } } } while (0)

struct XcdBarrier {
    unsigned* bar; unsigned x;
    volatile LAS unsigned* st;
};

__device__ __forceinline__ XcdBarrier xcd_barrier_post(unsigned* bar, volatile LAS unsigned* st) {
    XcdBarrier b; b.bar = bar; b.x = xb_xcc_id(); b.st = st;
    if (threadIdx.x == 0) (void)xb_add(&bar[XB_XCNT(b.x)], 1u);
    return b;
}
__device__ __forceinline__ void xcd_barrier_complete(unsigned* bar, unsigned x, unsigned& nloc, unsigned& nx) {
    const unsigned G = gridDim.x * gridDim.y * gridDim.z;
    unsigned sum, cnt, mine, sp = 0u;
    for (;;) {
        sum = 0u; cnt = 0u; mine = 0u;
#pragma unroll
        for (unsigned j = 0; j < 16; ++j) { const unsigned c = xb_ld(&bar[XB_XCNT(j)]); sum += c; cnt += (c > 0u) ? 1u : 0u; mine = (j == x) ? c : mine; }
        if (sum == G) break;
        __builtin_amdgcn_s_sleep(1);
        if ((++sp & 255u) == 0u) { if (xb_ld(&bar[XB_TMO])) break; if (sp > XB_SPIN_CAP) { atomicAdd(&bar[XB_TMO], 1u); break; } }
    }
    nloc = mine > 0u ? mine : 1u; nx = cnt > 0u ? cnt : 1u;
}

__device__ __forceinline__ void xcd_barrier(const XcdBarrier& b) {
    asm volatile("s_waitcnt vmcnt(0)" ::: "memory");
    __syncthreads();
    if (threadIdx.x == 0) {
        unsigned* bar = b.bar;
        __builtin_amdgcn_s_waitcnt(0);
        unsigned nloc = b.st[0], nx = b.st[1];
        if (nloc == 0u) { xcd_barrier_complete(bar, b.x, nloc, nx); b.st[0] = nloc; b.st[1] = nx; }
        const unsigned old = xb_add(&bar[XB_XSUB(b.x)], 1u);
        const unsigned gen = old / nloc;
        if (old + 1u == (gen + 1u) * nloc) {
            __builtin_amdgcn_fence(__ATOMIC_RELEASE, "agent");
            asm volatile("s_waitcnt vmcnt(0)" ::: "memory");
            const unsigned og = xb_add(&bar[XB_TOP], 1u);
            const unsigned tg = og / nx;
            if (og + 1u == (tg + 1u) * nx) xb_add(&bar[XB_TOPGEN], 1u);
            else XB_SPIN(xb_ld(&bar[XB_TOPGEN]) == tg, bar);
            __builtin_amdgcn_fence(__ATOMIC_ACQUIRE, "agent");
            xb_add(&bar[XB_XGEN(b.x)], 1u);
            asm volatile("s_waitcnt vmcnt(0)" ::: "memory");
        } else {
            XB_SPIN(xb_ld(&bar[XB_XGEN(b.x)]) == gen, bar);
            __builtin_amdgcn_fence(__ATOMIC_ACQUIRE, "agent");
            asm volatile("s_waitcnt vmcnt(0)" ::: "memory");
        }
    }
    __syncthreads();
}


DI void gsync(const Params& p) { XcdBarrier xb; xb.bar = (unsigned*)(p.ws + WS_BAR); xb.x = xb_xcc_id(); xb.st = (volatile LAS unsigned*)(smem + LDS_BYTES - 32); xcd_barrier(xb); }
template <int LAYER>
DI void layer_phases(const Params& p) {
  constexpr int B0 = 1 + 7 * LAYER;
#define PH_ON(k) (p.ph_lo <= (k) && (k) <= p.ph_hi)
#define PH_SYNC(k) do { if (p.ph_lo <= (k) && (k) < p.ph_hi) gsync(p); } while (0)
  if (PH_ON(B0 + 0)) { phase_rows(p, LAYER); phase_convert(p, LAYER); }
  PH_SYNC(B0 + 0);
  if (PH_ON(B0 + 1)) { phase_gemm1(p, LAYER); phase_gates(p); }
  PH_SYNC(B0 + 1);
  if (PH_ON(B0 + 2)) phase_qknorm(p, LAYER);
  PH_SYNC(B0 + 2);
  if (PH_ON(B0 + 3)) phase_x(p, LAYER);
  PH_SYNC(B0 + 3);
  if (PH_ON(B0 + 4)) phase_y(p, LAYER);
  PH_SYNC(B0 + 4);
  if (PH_ON(B0 + 5)) phase_yc(p, LAYER);
  PH_SYNC(B0 + 5);
  if (PH_ON(B0 + 6)) phase_gemm2(p, LAYER);
  PH_SYNC(B0 + 6);
}
__global__ void __launch_bounds__(512) fwd_megakernel(Params p) {
  cg::grid_group grid = cg::this_grid();
  volatile LAS unsigned* st = (volatile LAS unsigned*)(smem + LDS_BYTES - 32);
  unsigned* bar = (unsigned*)(p.ws + WS_BAR);
  if (threadIdx.x == 0) { st[0] = 0u; st[1] = 0u; }
  if (blockIdx.x == 0) { for (int i = threadIdx.x; i < XCD_BAR_WORDS; i += 512) bar[i] = 0u; }
  if (PH_ON(0)) phase_mod(p);
  grid.sync();
  (void)xcd_barrier_post(bar, st);
  layer_phases<0>(p);
  layer_phases<1>(p);
  if (PH_ON(15)) phase_final_ln(p);
}

extern "C" void kernel_launch(void* const* d_in, const int* in_sizes, int n_in, void* d_out, int out_size, void* d_ws, size_t ws_size, hipStream_t stream) {
  static int grid_blocks = 0;
  if (!grid_blocks) {
    if (ws_size < WS_END) { fprintf(stderr, "kernel_launch: workspace too small: %zu < %zu\n", ws_size, (size_t)WS_END); return; }
    if (hipFuncSetAttribute((const void*)fwd_megakernel, hipFuncAttributeMaxDynamicSharedMemorySize, LDS_BYTES) != hipSuccess) { fprintf(stderr, "kernel_launch: LDS attribute failed\n"); return; }
    int dev = 0, cus = 0, per_cu = 0;
    hipGetDevice(&dev);
    hipDeviceGetAttribute(&cus, hipDeviceAttributeMultiprocessorCount, dev);
    hipOccupancyMaxActiveBlocksPerMultiprocessor(&per_cu, fwd_megakernel, 512, LDS_BYTES);
    if (per_cu < 1) { fprintf(stderr, "kernel_launch: occupancy query returned %d\n", per_cu); return; }
    grid_blocks = cus;
  }
  Params p{};
  p.x = (const float*)d_in[0]; p.c = (const float*)d_in[1]; p.ctx = (const float*)d_in[2]; p.c_ctx = (const float*)d_in[3];
  p.w_mod = (const float*)d_in[4]; p.b_mod = (const float*)d_in[5]; p.w_in = (const float*)d_in[6]; p.q_norm = (const float*)d_in[7];
  p.k_norm = (const float*)d_in[8]; p.rpb = (const float*)d_in[9]; p.conv_w = (const float*)d_in[10]; p.a_log = (const float*)d_in[11];
  p.dt_bias = (const float*)d_in[12]; p.o_norm = (const float*)d_in[13]; p.w_out = (const float*)d_in[14]; p.ln_g = (const float*)d_in[15]; p.ln_b = (const float*)d_in[16];
  p.out = (float*)d_out; p.ws = (char*)d_ws; p.ph_lo = 0; p.ph_hi = 15;
  void* args[] = {&p};
  hipError_t e = hipLaunchCooperativeKernel((void*)fwd_megakernel, dim3(grid_blocks), dim3(512), args, LDS_BYTES, stream);
  if (e != hipSuccess) fprintf(stderr, "cooperative launch failed: %s (grid %d)\n", hipGetErrorString(e), grid_blocks);
}
```

```cpp
#include <hip/hip_runtime.h>
#include <hip/hip_cooperative_groups.h>
#include <cstdio>
#include <cstdint>
namespace cg = cooperative_groups;

#define DI __device__ __forceinline__
typedef unsigned short bf16_t;
using bf16x8 = __attribute__((ext_vector_type(8))) short;
using s16x4  = __attribute__((ext_vector_type(4))) short;
using f32x4  = __attribute__((ext_vector_type(4))) float;
using f32x16 = __attribute__((ext_vector_type(16))) float;
using u32x4  = __attribute__((ext_vector_type(4))) unsigned;
using u32x2  = __attribute__((ext_vector_type(2))) unsigned;

constexpr int DM = 2048, NBATCH = 4, SEQ = 4096, CTX = 256, TPB = 4352  , MTOK = NBATCH * TPB;
constexpr int INW = 6672, NP = 6784  , NPW = 6656  , HD = 128;
constexpr int C_QA = 0, C_KA = 1024, C_VA = 1280, C_ZA = 1536, C_QB = 2560, C_KB = 3072, C_VB = 3584, C_ZB = 4096, C_QC = 4608, C_ZC = 6144;
constexpr int NCH = 68;
constexpr float EPS = 1e-6f;
constexpr float ALPHA = 1.4142135623730951f;

constexpr size_t al256(size_t x) { return (x + 255) / 256 * 256; }
constexpr size_t WS_MOD  = 0;
constexpr size_t WS_CTR  = al256(WS_MOD + 2 * 5 * 6144 * 4);
constexpr size_t WS_BAR  = WS_CTR + 256;
constexpr size_t WS_WINT = al256(WS_BAR + 3456 * 4);
constexpr size_t WS_WG   = al256(WS_WINT + (size_t)NPW * DM * 2);
constexpr size_t WS_WOUT = al256(WS_WG + (size_t)64 * DM * 2);
constexpr size_t WS_HC   = al256(WS_WOUT + (size_t)DM * DM * 2);
constexpr size_t WS_P    = al256(WS_HC + (size_t)MTOK * DM * 2);
constexpr size_t WS_GT   = al256(WS_P + (size_t)MTOK * NP * 2);
constexpr size_t WS_CTX1 = al256(WS_GT + (size_t)MTOK * 16 * 4);
constexpr size_t WS_OF   = al256(WS_CTX1 + (size_t)NBATCH * CTX * DM * 4);
constexpr size_t WS_OB   = al256(WS_OF + (size_t)MTOK * 512 * 2);
constexpr size_t WS_QN   = al256(WS_OB + (size_t)MTOK * 512 * 2);
constexpr size_t WS_KT   = al256(WS_QN + (size_t)16 * NCH * 64 * 128 * 2);
constexpr size_t WS_W    = al256(WS_KT + (size_t)16 * NCH * 64 * 128 * 2);
constexpr size_t WS_U    = al256(WS_W + (size_t)32 * NCH * 64 * 128 * 2);
constexpr size_t WS_QK   = al256(WS_U + (size_t)32 * NCH * 64 * 128 * 2);
constexpr size_t WS_GC   = al256(WS_QK + (size_t)32 * NCH * 64 * 64 * 2);
constexpr size_t WS_END  = al256(WS_GC + (size_t)32 * NCH * 136 * 4);

constexpr int LDS_BYTES = 150016;

struct Params {
  const float *x, *c, *ctx, *c_ctx, *w_mod, *b_mod, *w_in, *q_norm, *k_norm, *rpb, *conv_w, *a_log, *dt_bias, *o_norm, *w_out, *ln_g, *ln_b;
  float* out; char* ws;
  int ph_lo, ph_hi;
};

extern __shared__ __attribute__((aligned(16))) char smem[];

DI bf16_t f2bf(float x) { unsigned u = __float_as_uint(x); u += 0x7fffu + ((u >> 16) & 1u); return (bf16_t)(u >> 16); }
DI float bf2f(bf16_t v) { return __uint_as_float(((unsigned)v) << 16); }
typedef __bf16 bf16v2 __attribute__((ext_vector_type(2)));
typedef float f32v2 __attribute__((ext_vector_type(2)));
DI unsigned pk2(float lo, float hi) { f32v2 v = {lo, hi}; return __builtin_bit_cast(unsigned, __builtin_convertvector(v, bf16v2)); }
DI float wave_sum(float v) { for (int o = 32; o; o >>= 1) v += __shfl_xor(v, o); return v; }
DI float silu_f(float v) { return v / (1.f + __expf(-v)); }
DI int invperm16(int off) { return 8 * ((off >> 2) & 1) + (off & 3) + 4 * (off >> 3); }
DI int perm_k(int k) { return (k & ~15) | invperm16(k & 15); }
DI int opaque_tid() { int t = threadIdx.x; asm volatile("" : "+v"(t)); return t; }
DI size_t pidx(int hidx, size_t tok) { return ((size_t)hidx * MTOK + tok) * 128; }
DI int crow(int r, int hi) { return (r & 3) + 8 * (r >> 2) + 4 * hi; }

DI void phase_mod(const Params& p) {
  const int tid = threadIdx.x;
  float* sc = (float*)smem;
  float* red = (float*)(smem + 40960);
  if (blockIdx.x == 0 && tid < 8) ((int*)(p.ws + WS_CTR))[tid] = 0;
  for (int i = tid; i < 5 * 2048; i += 512) { float v = i < 4 * 2048 ? p.c[i] : p.c_ctx[i - 4 * 2048]; sc[i] = silu_f(v); }
  __syncthreads();
  float* MOD = (float*)(p.ws + WS_MOD);
  for (int t = blockIdx.x; t < 192; t += gridDim.x) {
    const int layer = t / 96, cg0 = (t % 96) * 64;
    const int cl = tid & 15, ks = tid >> 4;
    const float* W = p.w_mod + (size_t)layer * DM * 6144 + cg0 + cl * 4;
    f32x4 a[5]; for (int r = 0; r < 5; ++r) a[r] = (f32x4){0.f, 0.f, 0.f, 0.f};
    for (int k = ks * 64; k < ks * 64 + 64; ++k) {
      const f32x4 w = *(const f32x4*)(W + (size_t)k * 6144);
#pragma unroll
      for (int r = 0; r < 5; ++r) a[r] += w * sc[r * 2048 + k];
    }
#pragma unroll
    for (int r = 0; r < 5; ++r) *(f32x4*)(red + (ks * 5 + r) * 64 + cl * 4) = a[r];
    __syncthreads();
    if (tid < 320) { const int r = tid >> 6, cc = tid & 63; float s = 0.f; for (int k2 = 0; k2 < 32; ++k2) s += red[(k2 * 5 + r) * 64 + cc];
      MOD[(layer * 5 + r) * 6144 + cg0 + cc] = s + p.b_mod[layer * 6144 + cg0 + cc]; }
    __syncthreads();
  }
}

DI void ln_stats(const f32x4 (&v)[8], float& mean, float& rstd) {
  float s = 0.f;
#pragma unroll
  for (int i = 0; i < 8; ++i) s += (v[i][0] + v[i][1]) + (v[i][2] + v[i][3]);
  s = wave_sum(s); mean = s * (1.f / 2048.f);
  float q = 0.f;
#pragma unroll
  for (int i = 0; i < 8; ++i) { f32x4 d = v[i] - mean; q += (d[0] * d[0] + d[1] * d[1]) + (d[2] * d[2] + d[3] * d[3]); }
  q = wave_sum(q); rstd = rsqrtf(q * (1.f / 2048.f) + EPS);
}

DI void phase_rows(const Params& p, int layer) {
  const int tid = threadIdx.x, wid = tid >> 6, lane = tid & 63;
  const float* MOD = (const float*)(p.ws + WS_MOD) + layer * 5 * 6144;
  bf16_t* H = (bf16_t*)(p.ws + WS_HC);
  float* CTX1 = (float*)(p.ws + WS_CTX1);
  for (int row = blockIdx.x * 8 + wid; row < MTOK; row += gridDim.x * 8) {
    const int b = row / TPB, tin = row % TPB; const bool isctx = tin < CTX;
    const float* src = isctx ? p.ctx + (size_t)(b * CTX + tin) * DM : p.x + (size_t)(b * SEQ + tin - CTX) * DM;
    f32x4 v[8];
#pragma unroll
    for (int i = 0; i < 8; ++i) v[i] = *(const f32x4*)(src + i * 256 + lane * 4);
    float mean, rstd;
    if (layer > 0) {
      const bf16_t* yr = (const bf16_t*)(p.ws + WS_P) + (size_t)row * DM;
      float* dst = isctx ? CTX1 + (size_t)(b * CTX + tin) * DM : p.out + (size_t)(b * SEQ + tin - CTX) * DM;
#pragma unroll
      for (int i = 0; i < 8; ++i) { const u32x2 yw = *(const u32x2*)(yr + i * 256 + lane * 4);
        const f32x4 yv = {__uint_as_float(yw.x << 16), __uint_as_float(yw.x & 0xffff0000u), __uint_as_float(yw.y << 16), __uint_as_float(yw.y & 0xffff0000u)};
        v[i] = v[i] * ALPHA + yv; }
      ln_stats(v, mean, rstd);
      const float* g = p.ln_g + (layer - 1) * DM; const float* bb = p.ln_b + (layer - 1) * DM;
#pragma unroll
      for (int i = 0; i < 8; ++i) { const f32x4 gg = *(const f32x4*)(g + i * 256 + lane * 4), b4 = *(const f32x4*)(bb + i * 256 + lane * 4);
        v[i] = (v[i] - mean) * rstd * gg + b4; if (!isctx) *(f32x4*)(dst + i * 256 + lane * 4) = v[i]; }
    }
    ln_stats(v, mean, rstd);
    const float* mr = MOD + (isctx ? 4 : b) * 6144;
#pragma unroll
    for (int i = 0; i < 8; ++i) { const int col = i * 256 + lane * 4;
      const f32x4 sh = *(const f32x4*)(mr + col), scl = *(const f32x4*)(mr + 2048 + col);
      const f32x4 h = (v[i] - mean) * rstd * (scl + 1.f) + sh;
      u32x2 w; w.x = pk2(h[0], h[1]); w.y = pk2(h[2], h[3]);
      *(u32x2*)(H + (size_t)row * DM + col) = w; }
  }
}

DI void phase_final_ln(const Params& p) {
  const int tid = threadIdx.x, wid = tid >> 6, lane = tid & 63;
  const float* g = p.ln_g + DM; const float* bb = p.ln_b + DM;
  for (int row = blockIdx.x * 8 + wid; row < NBATCH * SEQ; row += gridDim.x * 8) {
    float* src = p.out + (size_t)row * DM;
    const bf16_t* yr = (const bf16_t*)(p.ws + WS_P) + ((size_t)(row / SEQ) * TPB + CTX + row % SEQ) * DM;
    f32x4 v[8];
#pragma unroll
    for (int i = 0; i < 8; ++i) { const u32x2 yw = *(const u32x2*)(yr + i * 256 + lane * 4);
      const f32x4 yv = {__uint_as_float(yw.x << 16), __uint_as_float(yw.x & 0xffff0000u), __uint_as_float(yw.y << 16), __uint_as_float(yw.y & 0xffff0000u)};
      v[i] = *(const f32x4*)(src + i * 256 + lane * 4) * ALPHA + yv; }
    float mean, rstd; ln_stats(v, mean, rstd);
#pragma unroll
    for (int i = 0; i < 8; ++i) { const f32x4 gg = *(const f32x4*)(g + i * 256 + lane * 4), b4 = *(const f32x4*)(bb + i * 256 + lane * 4);
      *(f32x4*)(src + i * 256 + lane * 4) = (v[i] - mean) * rstd * gg + b4; }
  }
}

DI void convert_weight(const float* W, int N, int ntn, bf16_t* WT, int t, int nbase) {
  const int tid = threadIdx.x;
  float* tile = (float*)smem;
  const int n0 = nbase + (t % ntn) * 64, k0 = (t / ntn) * 64;
  { const int kr = tid >> 4, c4 = (tid & 15) * 4;
#pragma unroll
    for (int pss = 0; pss < 2; ++pss) { const int k = kr + pss * 32;
      f32x4 w = (f32x4){0.f, 0.f, 0.f, 0.f};
      if (n0 + c4 < N) w = *(const f32x4*)(W + (size_t)(k0 + k) * N + n0 + c4);
      tile[k * 65 + c4] = w[0]; tile[k * 65 + c4 + 1] = w[1]; tile[k * 65 + c4 + 2] = w[2]; tile[k * 65 + c4 + 3] = w[3]; } }
  __syncthreads();
  { const int n = tid >> 3, k8 = (tid & 7) * 8;
    u32x4 w; w.x = pk2(tile[(k8 + 0) * 65 + n], tile[(k8 + 1) * 65 + n]); w.y = pk2(tile[(k8 + 2) * 65 + n], tile[(k8 + 3) * 65 + n]);
    w.z = pk2(tile[(k8 + 4) * 65 + n], tile[(k8 + 5) * 65 + n]); w.w = pk2(tile[(k8 + 6) * 65 + n], tile[(k8 + 7) * 65 + n]);
    *(u32x4*)(WT + (size_t)(n0 - nbase + n) * DM + k0 + k8) = w; }
  __syncthreads();
}
DI void phase_convert(const Params& p, int layer) {
  const int T1 = (NPW / 64) * 32, T2 = 32 * 32, T3 = 32;
  for (int t = blockIdx.x; t < T1 + T2 + T3; t += gridDim.x) {
    if (t < T1) convert_weight(p.w_in + (size_t)layer * DM * INW, INW, NPW / 64, (bf16_t*)(p.ws + WS_WINT), t, 0);
    else if (t < T1 + T2) convert_weight(p.w_out + (size_t)layer * DM * DM, DM, 32, (bf16_t*)(p.ws + WS_WOUT), t - T1, 0);
    else convert_weight(p.w_in + (size_t)layer * DM * INW, INW, 1, (bf16_t*)(p.ws + WS_WG), t - T1 - T2, NPW);
  }
}

namespace pg8 {
#define PG8_LAS __attribute__((address_space(3)))
typedef unsigned short bf16_t;
typedef short bf16x8 __attribute__((ext_vector_type(8)));
typedef float f32x4 __attribute__((ext_vector_type(4)));
typedef unsigned u32x4 __attribute__((ext_vector_type(4)));
constexpr int BM = 256, BK = 64, HALF = 128, HTB = HALF * BK * 2  , STAGE_BYTES = 8 * HTB, NXCD = 8, WGM = 8;

__host__ __device__ __forceinline__ int lds_byte(int r, int c) { const int st = (r >> 4) * 2 + (c >> 5), rr = r & 15, cc = c & 31, ob = rr * 64 + cc * 2; return st * 1024 + (ob ^ (((ob >> 9) & 1) << 5)); }
__host__ __device__ __forceinline__ void stage_rc(int b, int& R, int& C) { const int st = b / 1024, sb = b % 1024, swz = sb ^ (((sb >> 9) & 1) << 5); R = (st >> 1) * 16 + swz / 64; C = (st & 1) * 32 + (swz % 64) / 2; }
__host__ __device__ __forceinline__ int perm32(int rho) { const int n = rho >> 4, i = rho & 15; return 8 * (i >> 2) + 4 * n + (i & 3); }

struct Unit { int pm, pn; };
struct Gemm { const bf16_t* A; const bf16_t* Bt; int M, N, K; };

struct StaticOrder {
    int nM, nN, nwg, G, c;
    __host__ __device__ void init(int M, int N, int G_, int c_) { nM = M / BM; nN = N / BM; nwg = nM * nN; G = G_; c = c_; }
    __host__ __device__ bool next(int i, Unit& u) const {
        const long L = (long)i * G + c; if (L >= nwg) return false;
        int wgid = (int)L; { const int q = nwg / NXCD, r = nwg % NXCD, xcd = wgid % NXCD, off = wgid / NXCD; wgid = (xcd < r ? xcd * (q + 1) : r * (q + 1) + (xcd - r) * q) + off; }
        const int nig = WGM * nN, gid = wgid / nig, fm = gid * WGM, gsz = (nM - fm) < WGM ? (nM - fm) : WGM;
        u.pm = fm + ((wgid % nig) % gsz); u.pn = (wgid % nig) / gsz; return true;
    }
    __device__ __forceinline__ void a_ready(const Unit&) const {}
    __device__ __forceinline__ void done(const Unit&) const {}
};

template <class Epi, class Sched, bool STAMP = false>
__device__ __forceinline__ void gemm_phase(PG8_LAS unsigned char* lds, const Gemm g, const Sched& S, const Epi& E, unsigned long long* stamps) {
    const int tid = threadIdx.x, wid = __builtin_amdgcn_readfirstlane(tid >> 6), lane = tid & 63, wr = wid >> 2, wc = wid & 3, fr = lane & 15, fq = lane >> 4;
    const int K = g.K, nt = K / BK;
    int ts_lo = 0, ts_hi = 0, nts = 0; const unsigned long long rt_entry = STAMP ? (unsigned long long)wall_clock64() : 0ull;
#define PG8_STAMP() do { if (STAMP && wid == 0 && nts < 64) { const unsigned long long _c = (unsigned long long)clock64(); \
        ts_lo = (lane == nts) ? (int)(unsigned)_c : ts_lo; ts_hi = (lane == nts) ? (int)(unsigned)(_c >> 32) : ts_hi; ++nts; } } while (0)
    PG8_STAMP();
    unsigned voffA[2], voffB[2];
#pragma unroll
    for (int i = 0; i < 2; ++i) { int R, C; stage_rc(tid * 16 + i * 8192, R, C); const int Rb = Epi::PERM ? ((R & ~31) + perm32(R & 31)) : R;
        voffA[i] = (unsigned)(R * K + C) * 2u; voffB[i] = (unsigned)(Rb * K + C) * 2u; }
    const size_t kstep = (size_t)(BK * 2);
    const size_t hstep = (size_t)HALF * K * 2;
    const size_t tstep = 2 * hstep;
    const unsigned ldsw = (unsigned)wid * 1024u;
    const int aoff = lds_byte(wr * 64 + fr, fq * 8), boff = lds_byte(wc * 32 + fr, fq * 8);
#define PG8_SA(b, h) (((b) * 2 + (h)) * HTB)
#define PG8_SB(b, h) ((4 + (b) * 2 + (h)) * HTB)
#define PG8_STAGE(bufoff, gbase, voff) do { _Pragma("unroll") for (int _i = 0; _i < 2; ++_i) \
        __builtin_amdgcn_global_load_lds((const unsigned*)((const char*)(gbase) + (voff)[_i]), (PG8_LAS unsigned*)(lds + (bufoff) + ldsw + _i * 8192), 16, 0, 0); } while (0)
#define PG8_LDA(dst, b, h) do { _Pragma("unroll") for (int m = 0; m < 4; ++m) _Pragma("unroll") for (int k = 0; k < 2; ++k) dst[m][k] = *(const PG8_LAS bf16x8*)(lds + PG8_SA(b, h) + aoff + m * 2048 + k * 1024); } while (0)
#define PG8_LDB(dst, b, h) do { _Pragma("unroll") for (int n = 0; n < 2; ++n) _Pragma("unroll") for (int k = 0; k < 2; ++k) dst[n][k] = *(const PG8_LAS bf16x8*)(lds + PG8_SB(b, h) + boff + n * 2048 + k * 1024); } while (0)
#define PG8_MMA(ai, bj, At, Bt) do { __builtin_amdgcn_s_setprio(1); _Pragma("unroll") for (int m = 0; m < 4; ++m) _Pragma("unroll") for (int n = 0; n < 2; ++n) _Pragma("unroll") for (int k = 0; k < 2; ++k) \
        acc[ai][bj][m][n] = __builtin_amdgcn_mfma_f32_16x16x32_bf16(Bt[n][k], At[m][k], acc[ai][bj][m][n], 0, 0, 0); __builtin_amdgcn_s_setprio(0); } while (0)
#define PG8_WAIT_V(n) asm volatile("s_waitcnt vmcnt(" #n ")" ::: "memory")
#define PG8_WAIT_L(n) asm volatile("s_waitcnt lgkmcnt(" #n ")" ::: "memory")
#define PG8_BAR __builtin_amdgcn_s_barrier()
#define PG8_SCHED __builtin_amdgcn_sched_barrier(0)
    Unit cur, nxt; int ui = 0;
    if (!S.next(0, cur)) return;
    f32x4 acc[2][2][4][2];
#pragma unroll
    for (int a = 0; a < 2; ++a)
#pragma unroll
        for (int b = 0; b < 2; ++b)
#pragma unroll
            for (int m = 0; m < 4; ++m)
#pragma unroll
                for (int n = 0; n < 2; ++n) acc[a][b][m][n] = (f32x4){0.f, 0.f, 0.f, 0.f};
    bf16x8 At[4][2], B0[2][2], B1[2][2];
    const char* cA = (const char*)g.A + (size_t)cur.pm * tstep; const char* cB = (const char*)g.Bt + (size_t)cur.pn * tstep;
    S.a_ready(cur);
    PG8_STAGE(PG8_SB(0, 0), cB, voffB); PG8_STAGE(PG8_SA(0, 0), cA, voffA); PG8_STAGE(PG8_SB(0, 1), cB + hstep, voffB); PG8_STAGE(PG8_SA(0, 1), cA + hstep, voffA);
    if (wr == 1) PG8_BAR;
    PG8_WAIT_V(4); PG8_BAR;
    PG8_STAGE(PG8_SB(1, 0), cB + kstep, voffB); PG8_STAGE(PG8_SA(1, 0), cA + kstep, voffA); PG8_STAGE(PG8_SB(1, 1), cB + hstep + kstep, voffB);
    PG8_WAIT_V(6); PG8_BAR;
    PG8_STAMP();
    for (;;) {
        const bool has_next = S.next(ui + 1, nxt);
        const char* nA = has_next ? (const char*)g.A + (size_t)nxt.pm * tstep : cA; const char* nB = has_next ? (const char*)g.Bt + (size_t)nxt.pn * tstep : cB;
        for (int t = 0; t < nt; t += 2) {
            const bool last = (t == nt - 2);
            const char* a1 = cA + (size_t)(t + 1) * kstep;
            const char* a2 = last ? nA : cA + (size_t)(t + 2) * kstep; const char* b2 = last ? nB : cB + (size_t)(t + 2) * kstep;
            const char* a3 = a2 + kstep; const char* b3 = b2 + kstep;
            if (last && has_next) S.a_ready(nxt);
            PG8_LDB(B0, 0, 0); PG8_SCHED; PG8_LDA(At, 0, 0); PG8_STAGE(PG8_SA(1, 1), a1 + hstep, voffA);
            PG8_WAIT_L(8); PG8_BAR; PG8_WAIT_L(0); PG8_MMA(0, 0, At, B0); PG8_BAR; PG8_SCHED;
            PG8_LDB(B1, 0, 1); PG8_STAGE(PG8_SB(0, 0), b2, voffB);
            PG8_BAR; PG8_WAIT_L(0); PG8_MMA(0, 1, At, B1); PG8_BAR;
            PG8_LDA(At, 0, 1); PG8_STAGE(PG8_SA(0, 0), a2, voffA);
            PG8_BAR; PG8_WAIT_L(0); PG8_MMA(1, 0, At, B0); PG8_BAR; PG8_SCHED;
            PG8_STAGE(PG8_SB(0, 1), b2 + hstep, voffB);
            PG8_WAIT_V(6); PG8_BAR; PG8_MMA(1, 1, At, B1); PG8_BAR;
            PG8_LDB(B0, 1, 0); PG8_SCHED; PG8_LDA(At, 1, 0); PG8_STAGE(PG8_SA(0, 1), a2 + hstep, voffA);
            PG8_WAIT_L(8); PG8_BAR; PG8_WAIT_L(0); PG8_MMA(0, 0, At, B0); PG8_BAR; PG8_SCHED;
            PG8_LDB(B1, 1, 1); PG8_STAGE(PG8_SB(1, 0), b3, voffB);
            PG8_BAR; PG8_WAIT_L(0); PG8_MMA(0, 1, At, B1); PG8_BAR;
            PG8_LDA(At, 1, 1); PG8_STAGE(PG8_SA(1, 0), a3, voffA);
            PG8_BAR; PG8_WAIT_L(0); PG8_MMA(1, 0, At, B0); PG8_BAR; PG8_SCHED;
            PG8_STAGE(PG8_SB(1, 1), b3 + hstep, voffB);
            PG8_WAIT_V(6); PG8_BAR; PG8_MMA(1, 1, At, B1); PG8_BAR;
        }
        PG8_STAMP();
        if constexpr (!Epi::AFTER_DRAIN) { E(acc, cur, wr, wc, fr, fq); S.done(cur); }
        PG8_STAMP();
        if (!has_next) break;
#pragma unroll
        for (int a = 0; a < 2; ++a)
#pragma unroll
            for (int b = 0; b < 2; ++b)
#pragma unroll
                for (int m = 0; m < 4; ++m)
#pragma unroll
                    for (int n = 0; n < 2; ++n) acc[a][b][m][n] = (f32x4){0.f, 0.f, 0.f, 0.f};
        cur = nxt; cA = nA; cB = nB; ++ui;
    }
    PG8_WAIT_V(0);
    if (wr == 0) PG8_BAR;
    PG8_BAR;
    if constexpr (Epi::AFTER_DRAIN) { E.fused(acc, cur, wr, wc, fr, fq, lds, wid, lane); S.done(cur); }
    PG8_STAMP();
    if (STAMP && wid == 0) { stamps[lane] = lane < nts ? (((unsigned long long)(unsigned)ts_hi << 32) | (unsigned)ts_lo) : 0ull;
        if (lane == 62) stamps[62] = rt_entry; if (lane == 63) stamps[63] = (unsigned long long)wall_clock64(); }
#undef PG8_STAMP
#undef PG8_SA
#undef PG8_SB
#undef PG8_STAGE
#undef PG8_LDA
#undef PG8_LDB
#undef PG8_MMA
#undef PG8_WAIT_V
#undef PG8_WAIT_L
#undef PG8_BAR
#undef PG8_SCHED
}
}

struct Epi1 {
  static constexpr bool PERM = true, AFTER_DRAIN = false;
  bf16_t* P;
  DI void operator()(const f32x4 (&acc)[2][2][4][2], const pg8::Unit& u, int wr, int wc, int fr, int fq) const {
    const int row0 = u.pm * 256 + wr * 64 + fr;
#pragma unroll
    for (int bj = 0; bj < 2; ++bj) { const int hidx = u.pn * 2 + bj;
      const bool sl = (hidx >= 12 && hidx < 20) || (hidx >= 32 && hidx < 36) || (hidx >= 48 && hidx < 52);
#pragma unroll
      for (int ai = 0; ai < 2; ++ai)
#pragma unroll
        for (int m = 0; m < 4; ++m) { f32x4 v0 = acc[ai][bj][m][0], v1 = acc[ai][bj][m][1];
          if (sl) { for (int e = 0; e < 4; ++e) { v0[e] = silu_f(v0[e]); v1[e] = silu_f(v1[e]); } }
          u32x4 w = {pk2(v0[0], v0[1]), pk2(v0[2], v0[3]), pk2(v1[0], v1[1]), pk2(v1[2], v1[3])};
          *(u32x4*)(P + pidx(hidx, row0 + ai * 128 + m * 16) + wc * 32 + 8 * fq) = w; } }
  }
};
struct Epi2 {
  static constexpr bool PERM = true, AFTER_DRAIN = false;
  const float* MOD; bf16_t* Y;
  DI void operator()(const f32x4 (&acc)[2][2][4][2], const pg8::Unit& u, int wr, int wc, int fr, int fq) const {
    const int b = u.pm / 17; const bool isctx = (u.pm % 17) == 0;
    const int row0 = u.pm * 256 + wr * 64 + fr, col0 = u.pn * 256 + wc * 32 + 8 * fq;
    const float* gate = MOD + (isctx ? 4 : b) * 6144 + 4096 + col0;
    f32x4 gv[2][2];
#pragma unroll
    for (int bj = 0; bj < 2; ++bj)
#pragma unroll
      for (int n = 0; n < 2; ++n) gv[bj][n] = *(const f32x4*)(gate + bj * 128 + 4 * n);
#pragma unroll
    for (int ai = 0; ai < 2; ++ai)
#pragma unroll
      for (int m = 0; m < 4; ++m) { bf16_t* rowp = Y + (size_t)(row0 + ai * 128 + m * 16) * DM + col0;
#pragma unroll
        for (int bj = 0; bj < 2; ++bj) { const f32x4 v0 = acc[ai][bj][m][0] * gv[bj][0], v1 = acc[ai][bj][m][1] * gv[bj][1];
          u32x4 w = {pk2(v0[0], v0[1]), pk2(v0[2], v0[3]), pk2(v1[0], v1[1]), pk2(v1[2], v1[3])};
          *(u32x4*)(rowp + bj * 128) = w; } }
  }
};
struct LatentOrder : pg8::StaticOrder {
  __device__ bool next(int i, pg8::Unit& u) const { if (!pg8::StaticOrder::next(i, u)) return false; u.pm = (u.pm >> 4) * 17 + 1 + (u.pm & 15); return true; }
};
DI void phase_gemm1(const Params& p, int layer) {
  pg8::Gemm g{(const bf16_t*)(p.ws + WS_HC), (const bf16_t*)(p.ws + WS_WINT), MTOK, NPW, DM};
  pg8::StaticOrder S; S.init(MTOK, NPW, gridDim.x, blockIdx.x);
  Epi1 E{(bf16_t*)(p.ws + WS_P)};
  pg8::gemm_phase<Epi1, pg8::StaticOrder, false>((PG8_LAS unsigned char*)smem, g, S, E, nullptr);
}
DI void phase_gates(const Params& p) {
  const int tid = opaque_tid(), wid = __builtin_amdgcn_readfirstlane(tid >> 6), lane = tid & 63, fr = lane & 15, fq = lane >> 4;
  const bf16_t* H = (const bf16_t*)(p.ws + WS_HC); const bf16_t* WG = (const bf16_t*)(p.ws + WS_WG); float* GT = (float*)(p.ws + WS_GT);
  f32x4* red = (f32x4*)smem;
  for (int rb = blockIdx.x; rb < MTOK / 68; rb += gridDim.x) {
    __syncthreads();
    f32x4 acc[5];
#pragma unroll
    for (int m = 0; m < 5; ++m) acc[m] = (f32x4){0.f, 0.f, 0.f, 0.f};
#pragma unroll
    for (int ks = 0; ks < 8; ++ks) { const int k0 = wid * 256 + ks * 32 + fq * 8;
      const bf16x8 bw = *(const bf16x8*)(WG + fr * DM + k0);
#pragma unroll
      for (int m = 0; m < 5; ++m) { const int ro = m < 4 ? m * 16 : 52;
        const bf16x8 a = *(const bf16x8*)(H + (size_t)(rb * 68 + ro + fr) * DM + k0);
        acc[m] = __builtin_amdgcn_mfma_f32_16x16x32_bf16(a, bw, acc[m], 0, 0, 0); } }
#pragma unroll
    for (int m = 0; m < 5; ++m) red[(wid * 5 + m) * 64 + lane] = acc[m];
    __syncthreads();
    if (tid < 320) { const int m = tid >> 6, ln = tid & 63; f32x4 sacc = red[m * 64 + ln];
#pragma unroll
      for (int w = 1; w < 8; ++w) sacc += red[(w * 5 + m) * 64 + ln];
      const int ro = m < 4 ? m * 16 : 52;
      float* g = GT + (size_t)(rb * 68 + ro + (ln >> 4) * 4) * 16 + (ln & 15);
      g[0] = sacc[0]; g[16] = sacc[1]; g[32] = sacc[2]; g[48] = sacc[3]; }
  }
}
DI void phase_gemm2(const Params& p, int layer) {
  pg8::Gemm g{(const bf16_t*)(p.ws + WS_HC), (const bf16_t*)(p.ws + WS_WOUT), MTOK, DM, DM};
  Epi2 E{(const float*)(p.ws + WS_MOD) + layer * 5 * 6144, (bf16_t*)(p.ws + WS_P)};
  if (layer == 0) { pg8::StaticOrder S; S.init(MTOK, DM, gridDim.x, blockIdx.x); pg8::gemm_phase<Epi2, pg8::StaticOrder, false>((PG8_LAS unsigned char*)smem, g, S, E, nullptr); }
  else { LatentOrder S; S.init(64 * 256, DM, gridDim.x, blockIdx.x); pg8::gemm_phase<Epi2, LatentOrder, false>((PG8_LAS unsigned char*)smem, g, S, E, nullptr); }
}

DI void phase_qknorm(const Params& p, int layer) {
  bf16_t* P = (bf16_t*)(p.ws + WS_P);
  const int l16 = threadIdx.x & 15, d8 = l16 * 8, stride = gridDim.x * 32;
  float invf[8];
#pragma unroll
  for (int e = 0; e < 8; ++e) invf[e] = exp2f(-(float)((d8 & 31) + e) * (13.287712379549449f / 32.f));
  for (int it0 = blockIdx.x * 32 + (threadIdx.x >> 4); it0 < MTOK * 10; it0 += stride * 4) {
    bf16x8 xin[4];
#pragma unroll
    for (int k = 0; k < 4; ++k) { const int it = it0 + k * stride; xin[k] = (bf16x8){0, 0, 0, 0, 0, 0, 0, 0};
      if (it < MTOK * 10) xin[k] = *(const bf16x8*)(P + pidx(it % 10, it / 10) + d8); }
#pragma unroll
    for (int k = 0; k < 4; ++k) { const int it = it0 + k * stride; const bool live = it < MTOK * 10;
      const int row = it / 10, hd = it % 10;
      float y[8]; float ss = 0.f;
#pragma unroll
      for (int e = 0; e < 8; ++e) { y[e] = bf2f((bf16_t)xin[k][e]); ss += y[e] * y[e]; }
      ss += __shfl_xor(ss, 1); ss += __shfl_xor(ss, 2); ss += __shfl_xor(ss, 4); ss += __shfl_xor(ss, 8);
      const float rs = rsqrtf(ss * (1.f / 128.f) + EPS);
      const float* gw = (hd < 8 ? p.q_norm : p.k_norm) + layer * HD + d8;
#pragma unroll
      for (int e = 0; e < 8; ++e) y[e] = y[e] * rs * gw[e];
      const int tin = row % TPB;
      float other[8];
#pragma unroll
      for (int e = 0; e < 8; ++e) other[e] = __shfl_xor(y[e], 4);
      if (tin >= CTX) { const int sq = tin - CTX; const float pos = (float)((d8 >> 6) == 0 ? (sq >> 6) : (sq & 63)); const bool part1 = (d8 >> 5) & 1;
#pragma unroll
        for (int e = 0; e < 8; ++e) { float sn, cs; __sincosf(pos * invf[e], &sn, &cs);
          y[e] = part1 ? (y[e] * cs + other[e] * sn) : (y[e] * cs - other[e] * sn); } }
      if (live) { u32x4 w = {pk2(y[0], y[1]), pk2(y[2], y[3]), pk2(y[4], y[5]), pk2(y[6], y[7])};
        *(u32x4*)(P + pidx(hd, row) + d8) = w; } }
  }
}

constexpr int KVBLK = 64;
constexpr float SCALE = 0.088388347648318440f;
constexpr float THR = 8.f;
constexpr size_t SHM_V = KVBLK * HD * 2, SHM_K = KVBLK * HD * 2;
#define KSWZ(row, colB) ((row) * 256 + ((colB) ^ (((row) & 7) << 4)))
#define SBAR() __builtin_amdgcn_sched_barrier(0)
DI unsigned cvtpk(float lo, float hi) { unsigned r; asm volatile("v_cvt_pk_bf16_f32 %0, %1, %2" : "=v"(r) : "v"(lo), "v"(hi)); return r; }

DI void partialSM(f32x16& p0, f32x16& p1, float& m_reg, float& mn, float& alpha) {
  constexpr float C = SCALE * 1.4426950408889634f;
  float pmax = p0[0];
#pragma unroll
  for (int r = 1; r < 16; ++r) pmax = fmaxf(pmax, p0[r]);
#pragma unroll
  for (int r = 0; r < 16; ++r) pmax = fmaxf(pmax, p1[r]);
  { auto rr = __builtin_amdgcn_permlane32_swap(__float_as_uint(pmax), __float_as_uint(pmax), false, false);
    pmax = fmaxf(__uint_as_float(rr[0]), __uint_as_float(rr[1])); }
  if (__builtin_expect(__all(pmax - m_reg <= THR / SCALE), 1)) { mn = m_reg; alpha = 1.f; }
  else { mn = fmaxf(m_reg, pmax); alpha = __builtin_amdgcn_exp2f((m_reg - mn) * C); m_reg = mn; }
  float mnC = -mn * C;
#pragma unroll
  for (int r = 0; r < 16; ++r) p0[r] = fmaf(p0[r], C, mnC);
#pragma unroll
  for (int r = 0; r < 16; ++r) p1[r] = fmaf(p1[r], C, mnC);
#pragma unroll
  for (int r = 0; r < 16; ++r) p0[r] = __builtin_amdgcn_exp2f(p0[r]);
}
DI void finishSM(f32x16& p0, f32x16& p1, float alpha, float& l_reg, bf16x8& pa0, bf16x8& pa1, bf16x8& pa2, bf16x8& pa3) {
#pragma unroll
  for (int r = 0; r < 16; ++r) p1[r] = __builtin_amdgcn_exp2f(p1[r]);
  float ps = 0;
#pragma unroll
  for (int r = 0; r < 16; ++r) ps += p0[r];
#pragma unroll
  for (int r = 0; r < 16; ++r) ps += p1[r];
  { auto rr = __builtin_amdgcn_permlane32_swap(__float_as_uint(ps), __float_as_uint(ps), false, false);
    ps = __uint_as_float(rr[0]) + __uint_as_float(rr[1]); }
  l_reg = l_reg * alpha + ps;
#define PK4(P, BASE, OUT) do { unsigned a0 = cvtpk(P[BASE + 0], P[BASE + 1]), a1 = cvtpk(P[BASE + 2], P[BASE + 3]);   \
    unsigned b0 = cvtpk(P[BASE + 4], P[BASE + 5]), b1 = cvtpk(P[BASE + 6], P[BASE + 7]);                              \
    auto r0 = __builtin_amdgcn_permlane32_swap(a0, b0, false, false); auto r1 = __builtin_amdgcn_permlane32_swap(a1, b1, false, false); \
    u32x4 w = {r0[0], r1[0], r0[1], r1[1]}; OUT = *reinterpret_cast<bf16x8*>(&w); } while (0)
  PK4(p0, 0, pa0); PK4(p0, 8, pa1); PK4(p1, 0, pa2); PK4(p1, 8, pa3);
#undef PK4
}
DI void qkt(f32x16& p0, f32x16& p1, const char* Ks, const bf16x8* qr, int r32, int hi) {
  p0 = f32x16{}; p1 = f32x16{};
#pragma unroll
  for (int d0 = 0; d0 < 8; ++d0) { int cb = (d0 * 16 + hi * 8) * 2;
    bf16x8 b0 = *reinterpret_cast<const bf16x8*>(Ks + KSWZ(r32, cb));
    bf16x8 b1 = *reinterpret_cast<const bf16x8*>(Ks + KSWZ(32 + r32, cb));
    p0 = __builtin_amdgcn_mfma_f32_32x32x16_bf16(b0, qr[d0], p0, 0, 0, 0);
    p1 = __builtin_amdgcn_mfma_f32_32x32x16_bf16(b1, qr[d0], p1, 0, 0, 0); }
}
DI int v_st(int k, int c) { const int kk = (k & ~0xC) | ((k & 4) << 1) | ((k & 8) >> 1); return ((kk >> 3) * 4 + (c >> 5)) * 512 + ((kk & 7) * 32 + (c & 31)) * 2; }
DI int v_rd_base(int lane) { return ((lane & 3) << 3) | (((lane >> 2) & 3) << 6) | (((lane >> 4) & 1) << 5) | (((lane >> 5) & 1) << 8); }
constexpr int v_rd_off(int d0, int ks, int half) { return d0 * 512 + ks * 4096 + half * 2048; }
template <int OFF> DI s16x4 tr_read(int vb) {
  s16x4 r; asm volatile("ds_read_b64_tr_b16 %0, %1 offset:%2" : "=&v"(r) : "v"(vb), "i"(OFF) : "memory"); return r;
}
template <int D0> DI void pv_one(f32x16& od, int vb, bf16x8 pa0, bf16x8 pa1, bf16x8 pa2, bf16x8 pa3) {
  const s16x4 l0 = tr_read<v_rd_off(D0, 0, 0)>(vb), h0 = tr_read<v_rd_off(D0, 0, 1)>(vb), l1 = tr_read<v_rd_off(D0, 1, 0)>(vb), h1 = tr_read<v_rd_off(D0, 1, 1)>(vb);
  const s16x4 l2 = tr_read<v_rd_off(D0, 2, 0)>(vb), h2 = tr_read<v_rd_off(D0, 2, 1)>(vb), l3 = tr_read<v_rd_off(D0, 3, 0)>(vb), h3 = tr_read<v_rd_off(D0, 3, 1)>(vb);
  asm volatile("s_waitcnt lgkmcnt(0)" ::: "memory"); SBAR();
#define PKV(L, H) (bf16x8){L[0], L[1], L[2], L[3], H[0], H[1], H[2], H[3]}
  od = __builtin_amdgcn_mfma_f32_32x32x16_bf16(pa0, PKV(l0, h0), od, 0, 0, 0);
  od = __builtin_amdgcn_mfma_f32_32x32x16_bf16(pa1, PKV(l1, h1), od, 0, 0, 0);
  od = __builtin_amdgcn_mfma_f32_32x32x16_bf16(pa2, PKV(l2, h2), od, 0, 0, 0);
  od = __builtin_amdgcn_mfma_f32_32x32x16_bf16(pa3, PKV(l3, h3), od, 0, 0, 0);
#undef PKV
}
DI void pv_d0(f32x16* o, int vb, bf16x8 pa0, bf16x8 pa1, bf16x8 pa2, bf16x8 pa3) {
  pv_one<0>(o[0], vb, pa0, pa1, pa2, pa3); pv_one<1>(o[1], vb, pa0, pa1, pa2, pa3); pv_one<2>(o[2], vb, pa0, pa1, pa2, pa3); pv_one<3>(o[3], vb, pa0, pa1, pa2, pa3);
}

DI void na_apply(f32x16& p0, f32x16& p1, int rk, int rq, int cq, const float* rpb_h, int hi) {
  const int r0 = min(max(rq - 4, 0), 56), c0 = min(max(cq - 8, 0), 48);
  const bool rowok = rk >= r0 && rk < r0 + 8;
  const float* bp = rpb_h + (rk - rq + 7) * 31 + 15 - cq;
#pragma unroll
  for (int r = 0; r < 16; ++r) { const int ck = crow(r, hi); const bool ok = rowok && ck >= c0 && ck < c0 + 16;
    float bias = 0.f; if (ok) bias = bp[ck]; p0[r] = ok ? p0[r] + bias * (1.f / SCALE) : -1e30f; }
#pragma unroll
  for (int r = 0; r < 16; ++r) { const int ck = 32 + crow(r, hi); const bool ok = rowok && ck >= c0 && ck < c0 + 16;
    float bias = 0.f; if (ok) bias = bp[ck]; p1[r] = ok ? p1[r] + bias * (1.f / SCALE) : -1e30f; }
}

template <bool NA, int SD>
DI void attn_body(const bf16_t* __restrict__ Qb, const bf16_t* __restrict__ Kb, const bf16_t* __restrict__ Vb, const bf16_t* __restrict__ Zb,
                  bf16_t* __restrict__ Ob, int NT, int rlo, int rq0, const float* rpb_h, float oscale = 1.f) {
  char* lds = smem;
  const int tid = opaque_tid(), wid = __builtin_amdgcn_readfirstlane(tid >> 6), lane = tid & 63, r32 = lane & 31, hi = lane >> 5;
  char* V_lds = lds; char* K_lds = lds + 2 * SHM_V;
  float* wsx = (float*)(lds + 2 * SHM_V + 2 * SHM_K) + wid * 64; float* li_l = wsx; float* al_l = wsx + 32;
  const int toff = NA ? 0 : rq0;
  float m_reg = -1e30f, l_reg = 0; f32x16 o[4] = {}; bf16x8 qr[8];
  const bf16_t* Qw = Qb + (size_t)(wid * 32 + r32) * HD + hi * 8;
#pragma unroll
  for (int d0 = 0; d0 < 8; ++d0) qr[d0] = *(const bf16x8*)(Qw + d0 * 16);
  const int sr = tid >> 4, sc = (tid & 15) * 8, vst0 = v_st(sr, sc), vst1 = v_st(32 + sr, sc);
  const int vb0 = (int)(uintptr_t)V_lds + v_rd_base(lane);
  const int rq = rq0 + (wid >> 1), cq = (wid & 1) * 32 + r32;
  struct { bf16x8 vs0, vs1, ks0, ks1; } sr_[SD];
#define TROW(j) (NA ? ((j) < 4 ? (j) * 64 : CTX + (rlo + (j) - 4) * 64) : (((j) + toff) % NT) * 64)
#define SLOAD(i, j) do { const size_t k0_ = (size_t)TROW(j); sr_[i].vs0 = *(const bf16x8*)(&Vb[(k0_ + sr) * HD + sc]); sr_[i].vs1 = *(const bf16x8*)(&Vb[(k0_ + 32 + sr) * HD + sc]); \
    sr_[i].ks0 = *(const bf16x8*)(&Kb[(k0_ + sr) * HD + sc]); sr_[i].ks1 = *(const bf16x8*)(&Kb[(k0_ + 32 + sr) * HD + sc]); } while (0)
#define SWRITE(b, i) do { *(bf16x8*)(V_lds + (b) * SHM_V + vst0) = sr_[i].vs0;          \
    *(bf16x8*)(V_lds + (b) * SHM_V + vst1) = sr_[i].vs1; int kc = sc * 2;               \
    *(bf16x8*)(K_lds + (b) * SHM_K + KSWZ(sr, kc)) = sr_[i].ks0;                       \
    *(bf16x8*)(K_lds + (b) * SHM_K + KSWZ(32 + sr, kc)) = sr_[i].ks1; } while (0)
#define SWAIT() do { if constexpr (SD == 2) asm volatile("s_waitcnt vmcnt(4)" ::: "memory"); else asm volatile("s_waitcnt vmcnt(0)" ::: "memory"); } while (0)
#define RESC(a) do { if (__any((a) < 1.f)) { if (hi == 0) al_l[r32] = (a); asm volatile("s_waitcnt lgkmcnt(0)" ::: "memory"); \
    for (int d = 0; d < 4; ++d) for (int r = 0; r < 16; ++r) o[d][r] *= al_l[crow(r, hi)]; } } while (0)
#define NAMASK(PA, PB, j) do { if (NA && (j) >= 4) na_apply(PA, PB, rlo + (j) - 4, rq, cq, rpb_h, hi); } while (0)
  f32x16 pA0, pA1, pB0, pB1; float mnA, mnB, alA, alB; bf16x8 pa0, pa1, pa2, pa3;
  constexpr int SE = 0, SO = SD - 1;
  SLOAD(SE, 0); asm volatile("s_waitcnt vmcnt(0)" ::: "memory"); SWRITE(0, SE); __syncthreads();
  qkt(pA0, pA1, K_lds, qr, r32, hi); NAMASK(pA0, pA1, 0); partialSM(pA0, pA1, m_reg, mnA, alA);
  SLOAD(SO, 1); if constexpr (SD == 2) { if (2 < NT) SLOAD(SE, 2); }
  SWAIT(); SWRITE(1, SO); __syncthreads();
  for (int j = 1; j + 1 < NT; j += 2) {
    SBAR(); qkt(pB0, pB1, K_lds + SHM_K, qr, r32, hi); NAMASK(pB0, pB1, j);
    finishSM(pA0, pA1, alA, l_reg, pa0, pa1, pa2, pa3); SBAR();
    SLOAD(SO, j + SD); SBAR();
    pv_d0(o, vb0, pa0, pa1, pa2, pa3); partialSM(pB0, pB1, m_reg, mnB, alB);
    __syncthreads(); SWAIT(); SWRITE(0, SE);
    RESC(alB); __syncthreads();
    SBAR(); qkt(pA0, pA1, K_lds, qr, r32, hi); NAMASK(pA0, pA1, j + 1);
    finishSM(pB0, pB1, alB, l_reg, pa0, pa1, pa2, pa3); SBAR();
    if (SD == 1 || j + 3 < NT) SLOAD(SE, j + 1 + SD); SBAR();
    pv_d0(o, vb0 + (int)SHM_V, pa0, pa1, pa2, pa3); partialSM(pA0, pA1, m_reg, mnA, alA);
    __syncthreads(); SWAIT(); SWRITE(1, SO);
    RESC(alA); __syncthreads();
  }
  SBAR(); qkt(pB0, pB1, K_lds + SHM_K, qr, r32, hi); NAMASK(pB0, pB1, NT - 1);
  finishSM(pA0, pA1, alA, l_reg, pa0, pa1, pa2, pa3); SBAR();
  pv_d0(o, vb0, pa0, pa1, pa2, pa3); partialSM(pB0, pB1, m_reg, mnB, alB);
  __syncthreads(); RESC(alB);
  finishSM(pB0, pB1, alB, l_reg, pa0, pa1, pa2, pa3); SBAR();
  pv_d0(o, vb0 + (int)SHM_V, pa0, pa1, pa2, pa3);
  if (hi == 0) li_l[r32] = l_reg; asm volatile("s_waitcnt lgkmcnt(0)" ::: "memory");
  float rli[16];
#pragma unroll
  for (int r = 0; r < 16; ++r) rli[r] = __builtin_amdgcn_rcpf(li_l[crow(r, hi)]);
  bf16_t* Ow = Ob + (size_t)(wid * 32) * DM; const bf16_t* Zw = Zb + (size_t)(wid * 32) * HD;
#pragma unroll
  for (int r = 0; r < 16; ++r) { const int orow = crow(r, hi);
#pragma unroll
    for (int d0 = 0; d0 < 4; ++d0) { const float gz = bf2f(Zw[(size_t)orow * HD + d0 * 32 + r32]);
      Ow[(size_t)orow * DM + d0 * 32 + r32] = f2bf(o[d0][r] * rli[r] * gz * oscale); } }
#undef SLOAD
#undef SWRITE
#undef SWAIT
#undef RESC
#undef NAMASK
#undef TROW
}

constexpr int PL_QS = 0, PL_KS = 17408, PL_VT = 34816, PL_KTT = 53248, PL_LM = 71680, PL_TU = 106496, PL_TW = 124928, PL_G = 143360;
DI void dn_prep(const Params& p, int layer, int task) {
  const int tid = opaque_tid(), wid = tid >> 6, lane = tid & 63, fr = lane & 15, fq = lane >> 4;
  const int bh = task / NCH, ch = task % NCH, b = bh >> 2, h = bh & 3;
  const size_t tok0 = (size_t)b * TPB + ch * 64;
  const bool has_left = !(ch == 0 || ch == 4), has_right = !(ch == 3 || ch == NCH - 1);
  const bf16_t* P = (const bf16_t*)(p.ws + WS_P); const float* GT = (const float*)(p.ws + WS_GT);
  bf16_t* qs = (bf16_t*)(smem + PL_QS); bf16_t* ks = (bf16_t*)(smem + PL_KS); bf16_t* vT = (bf16_t*)(smem + PL_VT); bf16_t* kT = (bf16_t*)(smem + PL_KTT);
  float* Lm = (float*)(smem + PL_LM); bf16_t* Tu = (bf16_t*)(smem + PL_TU); bf16_t* Tw = (bf16_t*)(smem + PL_TW);
  float* gbeta = (float*)(smem + PL_G); float* ggc = gbeta + 128; float* geg = gbeta + 256;
  bf16_t* QN = (bf16_t*)(p.ws + WS_QN) + (size_t)(bh * NCH + ch) * 64 * 128;
  bf16_t* KTg = (bf16_t*)(p.ws + WS_KT) + (size_t)(bh * NCH + ch) * 128 * 64;

  float* ssbuf = (float*)(smem + 144896);
  if (tid < 128) ssbuf[tid] = 0.f;
  __syncthreads();
  if (wid < 2) { const int dir = wid;
    const float* gr = GT + (tok0 + lane) * 16 + dir * 8;
    const float beta = 1.f / (1.f + __expf(-gr[h]));
    const float a = gr[4 + h] + p.dt_bias[layer * 8 + dir * 4 + h];
    const float sp = a > 20.f ? a : log1pf(__expf(a));
    float x = -__expf(p.a_log[layer * 8 + dir * 4 + h]) * sp;
    if (dir == 0) { for (int o = 1; o < 64; o <<= 1) { float t = __shfl_up(x, o); if (lane >= o) x += t; } }
    else { for (int o = 1; o < 64; o <<= 1) { float t = __shfl_down(x, o); if (lane + o < 64) x += t; } }
    const float glast = __shfl(x, dir == 0 ? 63 : 0);
    const float eg = __expf(x);
    gbeta[dir * 64 + lane] = beta; ggc[dir * 64 + lane] = x; geg[dir * 64 + lane] = eg;
    float* GC = (float*)(p.ws + WS_GC) + (size_t)((bh * 2 + dir) * NCH + ch) * 136;
    GC[lane] = eg; GC[64 + lane] = __expf(glast - x); if (lane == 0) GC[128] = __expf(glast);
  }
  SBAR();
  bf16_t* raw = (bf16_t*)(smem + PL_LM);
  { bf16x8 rv[7];
#pragma unroll
    for (int i = 0; i < 7; ++i) { const int idx = tid + i * 512, rr = idx >> 4, ck = idx & 15, which = rr / 66, lr = rr % 66;
      rv[i] = (bf16x8){0, 0, 0, 0, 0, 0, 0, 0};
      if (idx < 3 * 66 * 16 && (lr > 0 || has_left) && (lr < 65 || has_right)) rv[i] = *(const bf16x8*)(P + pidx(36 + which * 4 + h, tok0 + lr - 1) + ck * 8); }
#pragma unroll
    for (int i = 0; i < 7; ++i) { const int idx = tid + i * 512, rr = idx >> 4, ck = idx & 15;
      if (idx < 3 * 66 * 16) *(bf16x8*)(raw + rr * 136 + ck * 8) = rv[i]; } }
  __syncthreads();
  float yv[6][8];
  const int wu = __builtin_amdgcn_readfirstlane(wid);
  { const int c = lane;
#pragma unroll
    for (int k = 0; k < 6; ++k) { const int chk = wu * 6 + k, which = chk >> 4, d8 = (chk & 15) * 8;
      const bf16_t* rp = raw + (which * 66 + c) * 136 + d8;
      const bf16x8 xm = *(const bf16x8*)rp, x0 = *(const bf16x8*)(rp + 136), xp = *(const bf16x8*)(rp + 272);
      const float* cw = p.conv_w + (size_t)layer * 3 * 1536 + which * 512 + h * 128 + d8;
      float ss = 0.f;
#pragma unroll
      for (int e = 0; e < 8; ++e) { float v = cw[e] * bf2f((bf16_t)xm[e]) + cw[1536 + e] * bf2f((bf16_t)x0[e]) + cw[3072 + e] * bf2f((bf16_t)xp[e]);
        v = silu_f(v); yv[k][e] = v; ss += v * v; }
      if (which < 2) atomicAdd(&ssbuf[which * 64 + c], ss); } }
  __syncthreads();
  { const int c = lane, cp = perm_k(c);
#pragma unroll
    for (int k = 0; k < 6; ++k) { const int chk = wu * 6 + k, which = chk >> 4, d8 = (chk & 15) * 8;
      float rn = 1.f; if (which < 2) rn = rsqrtf(ssbuf[which * 64 + c] + EPS) * (which == 0 ? 0.088388347648318440f : 1.f);
      float y[8];
#pragma unroll
      for (int e = 0; e < 8; ++e) y[e] = yv[k][e] * rn;
      if (which == 0) { u32x4 w = {pk2(y[0], y[1]), pk2(y[2], y[3]), pk2(y[4], y[5]), pk2(y[6], y[7])};
        *(u32x4*)(qs + c * 136 + d8) = w;
        bf16_t* qd = QN + c * 128; const int c0 = (d8 >> 4) * 2, sw = c & 15, wi = (d8 & 8) ? 4 : 0;
        *(u32x2*)(qd + ((c0 ^ sw) << 3) + wi) = (u32x2){w.x, w.y}; *(u32x2*)(qd + (((c0 + 1) ^ sw) << 3) + wi) = (u32x2){w.z, w.w};
      } else if (which == 1) { u32x4 w = {pk2(y[0], y[1]), pk2(y[2], y[3]), pk2(y[4], y[5]), pk2(y[6], y[7])};
        *(u32x4*)(ks + c * 136 + d8) = w;
#pragma unroll
        for (int e = 0; e < 8; ++e) { const bf16_t kv = f2bf(y[e]); const int d = d8 + e; kT[d * 72 + c] = kv; KTg[d * 64 + ((((cp >> 3) ^ ((d >> 1) & 7)) << 3) | (cp & 7))] = kv; }
      } else {
#pragma unroll
        for (int e = 0; e < 8; ++e) vT[(d8 + e) * 72 + c] = f2bf(y[e]);
      } } }
  __syncthreads();
  SBAR();
  { const int sel = wid >> 2, mi = wid & 3;
    const bf16_t* Ar = (sel == 0 ? ks : qs) + (mi * 16 + fr) * 136 + fq * 8;
    f32x4 acc[4];
#pragma unroll
    for (int n = 0; n < 4; ++n) acc[n] = (f32x4){0.f, 0.f, 0.f, 0.f};
#pragma unroll
    for (int kk = 0; kk < 4; ++kk) { const bf16x8 a = *(const bf16x8*)(Ar + kk * 32);
#pragma unroll
      for (int n = 0; n < 4; ++n) { const bf16x8 bb = *(const bf16x8*)(ks + (n * 16 + fr) * 136 + kk * 32 + fq * 8);
        acc[n] = __builtin_amdgcn_mfma_f32_16x16x32_bf16(a, bb, acc[n], 0, 0, 0); } }
    bf16_t* QKg = (bf16_t*)(p.ws + WS_QK);
#pragma unroll
    for (int n = 0; n < 4; ++n)
#pragma unroll
      for (int j = 0; j < 4; ++j) { const int i = mi * 16 + fq * 4 + j, jj = n * 16 + fr; const float val = acc[n][j];
#pragma unroll
        for (int dir = 0; dir < 2; ++dir) { const float e = __expf(fminf(ggc[dir * 64 + i] - ggc[dir * 64 + jj], 0.f));
          if (sel == 0) { const bool ok = dir == 0 ? (i > jj) : (i < jj); const float lv = ok ? gbeta[dir * 64 + i] * val * e : 0.f;
            const int i2 = dir == 0 ? i : 63 - i, j2 = dir == 0 ? jj : 63 - jj; Lm[(dir * 64 + i2) * 68 + j2] = lv; }
          else { const bool ok = dir == 0 ? (i >= jj) : (i <= jj);
            const int pj = perm_k(jj);
            QKg[((size_t)((bh * 2 + dir) * NCH + ch) * 64 + i) * 64 + ((((pj >> 3) ^ ((i >> 1) & 7)) << 3) | (pj & 7))] = f2bf(ok ? val * e : 0.f); } } }
  }
  __syncthreads();
  SBAR();
  if (wid < 2) { const int dir = wid; const float* Lr = Lm + dir * 64 * 68;
    float t[64];
#pragma unroll
    for (int i = 0; i < 64; ++i) t[i] = 0.f;
#pragma unroll
    for (int i = 0; i < 64; ++i) { float a0 = (i == lane) ? 1.f : 0.f, a1 = 0.f, a2 = 0.f, a3 = 0.f;
#pragma unroll
      for (int j4 = 0; j4 < (i + 3) / 4; ++j4) { const f32x4 l = *(const f32x4*)(Lr + i * 68 + j4 * 4);
        a0 -= l[0] * t[j4 * 4]; a1 -= l[1] * t[j4 * 4 + 1]; a2 -= l[2] * t[j4 * 4 + 2]; a3 -= l[3] * t[j4 * 4 + 3]; }
      const float a = (a0 + a1) + (a2 + a3);
      t[i] = a; Lm[(dir * 64 + i) * 68 + lane] = a; }
  }
  __syncthreads();
  SBAR();
#pragma unroll 1
  for (int i = 0; i < 16; ++i) { const int idx = tid + i * 512, dir = idx >> 12, i2 = (idx >> 6) & 63, j2 = idx & 63;
    const float tv = Lm[(dir * 64 + i2) * 68 + j2];
    const int ir = dir == 0 ? i2 : 63 - i2, jc = dir == 0 ? j2 : 63 - j2;
    const float bj = gbeta[dir * 64 + jc];
    Tu[(dir * 64 + ir) * 72 + jc] = f2bf(tv * bj); Tw[(dir * 64 + ir) * 72 + jc] = f2bf(tv * bj * geg[dir * 64 + jc]); }
  __syncthreads();
  SBAR();
  { const int mat = wid >> 1, nh = wid & 1, dir = mat & 1, isw = mat >> 1;
    const bf16_t* Am = (isw ? Tw : Tu) + dir * 64 * 72; const bf16_t* Bm = isw ? kT : vT;
    f32x4 acc[4][4];
#pragma unroll
    for (int m = 0; m < 4; ++m)
#pragma unroll
      for (int n = 0; n < 4; ++n) acc[m][n] = (f32x4){0.f, 0.f, 0.f, 0.f};
#pragma unroll
    for (int kk = 0; kk < 2; ++kk) { bf16x8 a[4], bb[4];
#pragma unroll
      for (int m = 0; m < 4; ++m) a[m] = *(const bf16x8*)(Am + (m * 16 + fr) * 72 + kk * 32 + fq * 8);
#pragma unroll
      for (int n = 0; n < 4; ++n) bb[n] = *(const bf16x8*)(Bm + ((nh * 4 + n) * 16 + fr) * 72 + kk * 32 + fq * 8);
#pragma unroll
      for (int m = 0; m < 4; ++m)
#pragma unroll
        for (int n = 0; n < 4; ++n) acc[m][n] = __builtin_amdgcn_mfma_f32_16x16x32_bf16(a[m], bb[n], acc[m][n], 0, 0, 0); }
    const size_t cb = (size_t)((bh * 2 + dir) * NCH + ch);
    bf16_t* Ul = (bf16_t*)(p.ws + WS_U) + cb * 64 * 128 + nh * 4096 + fr * 16 + (fq & 1) * 512 + (fq >> 1) * 4;
    bf16_t* Wl = (bf16_t*)(p.ws + WS_W) + cb * 64 * 128 + fq * 512; const int wp = invperm16(fr);
    if (isw) {
#pragma unroll
      for (int m = 0; m < 4; ++m)
#pragma unroll
        for (int n = 0; n < 4; ++n)
#pragma unroll
          for (int j = 0; j < 4; ++j) Wl[(m * 16 + j) * 128 + (((((nh * 4 + n) * 2 + (wp >> 3)) ^ (fq * 4 + j)) << 3) | (wp & 7))] = f2bf(-acc[m][n][j]);
    } else {
#pragma unroll
      for (int m = 0; m < 4; ++m)
#pragma unroll
        for (int n = 0; n < 4; ++n) { u32x2 w = {pk2(acc[m][n][0], acc[m][n][1]), pk2(acc[m][n][2], acc[m][n][3])};
          *(u32x2*)(Ul + (n >> 1) * 2048 + (m >> 1) * 1024 + (n & 1) * 256 + 8 * (m & 1)) = w; }
    }
  }
  __syncthreads();
}

constexpr int SC_W = 0, SC_QN = 16384, SC_QK = 32768, SC_KT = 40960, SC_U = 57344, SC_GC = 73728, SC_BUF = 74752;
DI bf16x8 pack8(const f32x16& x, int s) {
  u32x4 w = {pk2(x[8 * s], x[8 * s + 1]), pk2(x[8 * s + 2], x[8 * s + 3]), pk2(x[8 * s + 4], x[8 * s + 5]), pk2(x[8 * s + 6], x[8 * s + 7])};
  return __builtin_bit_cast(bf16x8, w);
}
#define MFMA32(a, b, c) __builtin_amdgcn_mfma_f32_32x32x16_bf16((a), (b), (c), 0, 0, 0)
DI int scan_chunk(int dir, int step) { return dir == 0 ? step : (step < 4 ? 3 - step : 71 - step); }
DI void scan_issue(const Params& p, int bh, int dir, int step, int buf, int ltid) {
  const int ch = scan_chunk(dir, step);
  const size_t cb = (size_t)((bh * 2 + dir) * NCH + ch), cq = (size_t)(bh * NCH + ch);
  const char* Wg = p.ws + WS_W + cb * 16384; const char* Ug = p.ws + WS_U + cb * 16384; const char* QKg = p.ws + WS_QK + cb * 8192;
  const char* GCg = p.ws + WS_GC + cb * 544; const char* QNg = p.ws + WS_QN + cq * 16384; const char* KTg = p.ws + WS_KT + cq * 16384;
  char* dst = smem + buf * SC_BUF; const int o = ltid * 16;
#pragma unroll
  for (int i = 0; i < 4; ++i) {
    __builtin_amdgcn_global_load_lds((const unsigned*)(Wg + o + i * 4096), (unsigned*)(dst + SC_W + o + i * 4096), 16, 0, 0);
    __builtin_amdgcn_global_load_lds((const unsigned*)(QNg + o + i * 4096), (unsigned*)(dst + SC_QN + o + i * 4096), 16, 0, 0);
    __builtin_amdgcn_global_load_lds((const unsigned*)(KTg + o + i * 4096), (unsigned*)(dst + SC_KT + o + i * 4096), 16, 0, 0);
    __builtin_amdgcn_global_load_lds((const unsigned*)(Ug + o + i * 4096), (unsigned*)(dst + SC_U + o + i * 4096), 16, 0, 0); }
#pragma unroll
  for (int i = 0; i < 2; ++i) __builtin_amdgcn_global_load_lds((const unsigned*)(QKg + o + i * 4096), (unsigned*)(dst + SC_QK + o + i * 4096), 16, 0, 0);
  if (ltid < 34) __builtin_amdgcn_global_load_lds((const unsigned*)(GCg + o), (unsigned*)(dst + SC_GC + o), 16, 0, 0);
}
DI void dn_scan_block(const Params& p, int bh, int dir) {
  const int tid = opaque_tid(), wid = __builtin_amdgcn_readfirstlane(tid >> 6), lane = tid & 63, r = lane & 31, hh = lane >> 5;
  const int b = bh >> 2, h = bh & 3, eb = wid & 3;
  const bool loader = wid >= 4;
  f32x16 S[4];
#pragma unroll
  for (int d = 0; d < 4; ++d) S[d] = f32x16{};
  bf16_t* Og = (bf16_t*)(p.ws + (dir == 0 ? WS_OF : WS_OB)) + (size_t)b * TPB * 512 + h * 128 + eb * 32 + r;
  __syncthreads();
  if (loader) { scan_issue(p, bh, dir, 0, 0, tid - 256); asm volatile("s_waitcnt vmcnt(0)" ::: "memory"); }
  __builtin_amdgcn_s_barrier(); asm volatile("" ::: "memory");
#pragma unroll 1
  for (int step = 0; step < NCH; ++step) {
    if (loader) {
      if (step + 1 < NCH) scan_issue(p, bh, dir, step + 1, (step + 1) & 1, tid - 256);
      asm volatile("s_waitcnt vmcnt(0)" ::: "memory");
    } else {
      const char* B = smem + (step & 1) * SC_BUF;
      const int ch = scan_chunk(dir, step);
      bf16x8 Sp[8];
#pragma unroll
      for (int d = 0; d < 4; ++d) { Sp[2 * d] = pack8(S[d], 0); Sp[2 * d + 1] = pack8(S[d], 1); }
      f32x16 VN[2], O[2];
#pragma unroll
      for (int ct = 0; ct < 2; ++ct) { const char* up = B + SC_U + ((eb * 2 + ct) * 64 + lane) * 32;
        const bf16x8 u0 = *(const bf16x8*)up, u1 = *(const bf16x8*)(up + 16);
#pragma unroll
        for (int i = 0; i < 8; ++i) { VN[ct][i] = bf2f((bf16_t)u0[i]); VN[ct][8 + i] = bf2f((bf16_t)u1[i]); }
        O[ct] = f32x16{}; }
#pragma unroll
      for (int ct = 0; ct < 2; ++ct) { const int R = ct * 32 + r;
#pragma unroll
        for (int ks = 0; ks < 8; ++ks) { const int co = (((ks * 2 + hh) ^ (R & 15)) << 4);
          const bf16x8 aw = *(const bf16x8*)(B + SC_W + R * 256 + co); VN[ct] = MFMA32(aw, Sp[ks], VN[ct]);
          const bf16x8 aq = *(const bf16x8*)(B + SC_QN + R * 256 + co); O[ct] = MFMA32(aq, Sp[ks], O[ct]); if (ks == 3 || ks == 7) SBAR(); } }
      const float* GC = (const float*)(B + SC_GC);
#pragma unroll
      for (int ct = 0; ct < 2; ++ct)
#pragma unroll
        for (int q4 = 0; q4 < 4; ++q4) { const f32x4 eg = *(const f32x4*)(GC + ct * 32 + 8 * q4 + 4 * hh);
#pragma unroll
          for (int i = 0; i < 4; ++i) O[ct][q4 * 4 + i] *= eg[i]; }
      bf16x8 Vp[4];
#pragma unroll
      for (int ct = 0; ct < 2; ++ct) { Vp[2 * ct] = pack8(VN[ct], 0); Vp[2 * ct + 1] = pack8(VN[ct], 1); }
#pragma unroll
      for (int ct = 0; ct < 2; ++ct) { const int R = ct * 32 + r;
#pragma unroll
        for (int ks = 0; ks < 4; ++ks) { const bf16x8 a = *(const bf16x8*)(B + SC_QK + R * 128 + (((ks * 2 + hh) ^ ((R >> 1) & 7)) << 4)); O[ct] = MFMA32(a, Vp[ks], O[ct]); } SBAR(); }
      { bf16_t* od = Og + (size_t)(ch * 64) * 512;
#pragma unroll
        for (int ct = 0; ct < 2; ++ct)
#pragma unroll
          for (int i = 0; i < 16; ++i) od[(size_t)(ct * 32 + crow(i, hh)) * 512] = f2bf(O[ct][i]); }
#pragma unroll
      for (int ct = 0; ct < 2; ++ct)
#pragma unroll
        for (int q4 = 0; q4 < 4; ++q4) { const f32x4 ek = *(const f32x4*)(GC + 64 + ct * 32 + 8 * q4 + 4 * hh);
#pragma unroll
          for (int i = 0; i < 4; ++i) VN[ct][q4 * 4 + i] *= ek[i]; }
#pragma unroll
      for (int ct = 0; ct < 2; ++ct) { Vp[2 * ct] = pack8(VN[ct], 0); Vp[2 * ct + 1] = pack8(VN[ct], 1); }
      const float egl = GC[128];
#pragma unroll
      for (int d = 0; d < 4; ++d) { const int R = d * 32 + r;
#pragma unroll
        for (int i = 0; i < 16; ++i) S[d][i] *= egl;
#pragma unroll
        for (int ks = 0; ks < 4; ++ks) { const bf16x8 a = *(const bf16x8*)(B + SC_KT + R * 128 + (((ks * 2 + hh) ^ ((R >> 1) & 7)) << 4)); S[d] = MFMA32(a, Vp[ks], S[d]); } SBAR(); }
      asm volatile("s_waitcnt lgkmcnt(0)" ::: "memory");
    }
    __builtin_amdgcn_s_barrier(); asm volatile("" ::: "memory");
  }
}

#ifndef PROBE_DUP
#define PROBE_DUP 0
#endif
DI void run_attn_unit(const Params& p, int layer, int kind, int id) {
  const bf16_t* P = (const bf16_t*)(p.ws + WS_P); bf16_t* CC = (bf16_t*)(p.ws + WS_HC);
  const bf16_t *Qp, *Kp, *Vp, *Zp; bf16_t* Op; int NT = 4, rlo = 0, rq0 = 0; const float* rp = nullptr;
  if (kind == 0) { const int qb = id & 15, h = (id >> 4) & 7, b = id >> 7; const size_t t0 = (size_t)b * TPB, q0 = t0 + CTX + qb * 256;
    Qp = P + pidx(h, q0); Kp = P + pidx(8 + (h >> 2), t0); Vp = P + pidx(10 + (h >> 2), t0); Zp = P + pidx(12 + h, q0);
    Op = CC + q0 * DM + h * 128; NT = TPB / 64; rq0 = ((((h & 3) * 16 + qb) * 4) % 68);
  } else if (kind == 1) { const int qb = id & 15, h = (id >> 4) & 3, b = id >> 6; const size_t t0 = (size_t)b * TPB, q0 = t0 + CTX + qb * 256;
    rq0 = qb * 4; rlo = min(max(rq0 - 4, 0), 52); NT = 16; rp = p.rpb + (size_t)(layer * 4 + h) * 15 * 31;
    Qp = P + pidx(20 + h, q0); Kp = P + pidx(24 + h, t0); Vp = P + pidx(28 + h, t0); Zp = P + pidx(32 + h, q0);
    Op = CC + q0 * DM + 1024 + h * 128;
  } else if (kind == 2) { const int h = id & 7, b = id >> 3; const size_t t0 = (size_t)b * TPB;
    Qp = P + pidx(h, t0); Kp = P + pidx(8 + (h >> 2), t0); Vp = P + pidx(10 + (h >> 2), t0); Zp = P + pidx(12 + h, t0);
    Op = CC + t0 * DM + h * 128;
  } else { const int h = id & 3, b = id >> 2; const size_t t0 = (size_t)b * TPB;
    Qp = P + pidx(20 + h, t0); Kp = P + pidx(24 + h, t0); Vp = P + pidx(28 + h, t0); Zp = P + pidx(32 + h, t0);
    Op = CC + t0 * DM + 1024 + h * 128;
  }
  if (kind == 1) attn_body<true, 1>(Qp, Kp, Vp, Zp, Op, NT, rlo, rq0, rp);
  else attn_body<false, 2>(Qp, Kp, Vp, Zp, Op, NT, 0, rq0, nullptr);
}
constexpr int AX = 288;
DI void phase_x(const Params& p, int layer, int pass = 0) {
  const int tid = threadIdx.x;
  int* ctr = (int*)(p.ws + WS_CTR) + layer * 2 + pass * 4;
  int* s_unit = (int*)(smem + LDS_BYTES - 16);
  const int total = AX + 16 * NCH + 256 + (layer == 0 ? 16 : 0);
  for (;;) {
    __syncthreads();
    if (tid == 0) *s_unit = atomicAdd(ctr, 1);
    __syncthreads();
    const int u = __builtin_amdgcn_readfirstlane(*s_unit);
    if (u >= total) break;
    if (u < AX) run_attn_unit(p, layer, 0, u);
    else if (u < AX + 16 * NCH) dn_prep(p, layer, u - AX);
    else if (u < AX + 16 * NCH + 256) run_attn_unit(p, layer, 1, u - AX - 16 * NCH);
    else run_attn_unit(p, layer, 3, u - AX - 16 * NCH - 256);
  }
}
DI void phase_y(const Params& p, int layer, int pass = 0) {
  const int tid = threadIdx.x;
  if (blockIdx.x < 32) dn_scan_block(p, blockIdx.x >> 1, blockIdx.x & 1);
  int* ctr = (int*)(p.ws + WS_CTR) + layer * 2 + 1 + pass * 4;
  int* s_unit = (int*)(smem + LDS_BYTES - 16);
  const int total = (512 - AX) + (layer == 0 ? 32 : 0);
  for (;;) {
    __syncthreads();
    if (tid == 0) *s_unit = atomicAdd(ctr, 1);
    __syncthreads();
    const int u = __builtin_amdgcn_readfirstlane(*s_unit);
    if (u >= total) break;
    if (u < 512 - AX) run_attn_unit(p, layer, 0, AX + u);
    else run_attn_unit(p, layer, 2, u - (512 - AX));
  }
}

DI void phase_yc(const Params& p, int layer) {
  const bf16_t* OF = (const bf16_t*)(p.ws + WS_OF); const bf16_t* OB = (const bf16_t*)(p.ws + WS_OB);
  const bf16_t* P = (const bf16_t*)(p.ws + WS_P); bf16_t* CC = (bf16_t*)(p.ws + WS_HC);
  const float* on = p.o_norm + layer * HD;
  const int l16 = threadIdx.x & 15, stride = gridDim.x * 32;
  for (int it0 = blockIdx.x * 32 + (threadIdx.x >> 4); it0 < MTOK * 4; it0 += stride * 4) {
    bf16x8 av[4], bv[4], zv[4];
#pragma unroll
    for (int k = 0; k < 4; ++k) { const int it = it0 + k * stride; av[k] = (bf16x8){0, 0, 0, 0, 0, 0, 0, 0}; bv[k] = av[k]; zv[k] = av[k];
      if (it < MTOK * 4 && !(layer == 1 && ((it >> 2) % TPB) < CTX)) { const int tok = it >> 2, h = it & 3; const size_t o = (size_t)tok * 512 + h * 128 + l16 * 8;
        av[k] = *(const bf16x8*)(OF + o); bv[k] = *(const bf16x8*)(OB + o); zv[k] = *(const bf16x8*)(P + pidx(48 + h, tok) + l16 * 8); } }
#pragma unroll
    for (int k = 0; k < 4; ++k) { const int it = it0 + k * stride; const int tok = it >> 2, h = it & 3;
      float y[8]; float ss = 0.f;
#pragma unroll
      for (int e = 0; e < 8; ++e) { y[e] = bf2f((bf16_t)av[k][e]) + bf2f((bf16_t)bv[k][e]); ss += y[e] * y[e]; }
      ss += __shfl_xor(ss, 1); ss += __shfl_xor(ss, 2); ss += __shfl_xor(ss, 4); ss += __shfl_xor(ss, 8);
      const float rs = rsqrtf(ss * (1.f / 128.f) + EPS);
#pragma unroll
      for (int e = 0; e < 8; ++e) y[e] = y[e] * rs * on[l16 * 8 + e] * bf2f((bf16_t)zv[k][e]);
      if (it < MTOK * 4 && !(layer == 1 && (tok % TPB) < CTX)) { u32x4 w = {pk2(y[0], y[1]), pk2(y[2], y[3]), pk2(y[4], y[5]), pk2(y[6], y[7])};
        *(u32x4*)(CC + (size_t)tok * DM + 1536 + h * 128 + l16 * 8) = w; } }
  }
}

#define XB_TMO      128
#define XB_XCNT(j)  (256  + 64 * (j))
#define XB_XSUB(j)  (1280 + 64 * (j))
#define XB_XGEN(j)  (2304 + 64 * (j))
#define XB_TOP      3328
#define XB_TOPGEN   3392
#define XCD_BAR_WORDS 3456
#define XB_SPIN_CAP (1u << 18)
#define LAS __attribute__((address_space(3)))

__device__ __forceinline__ unsigned xb_ld(unsigned* p)              { return __hip_atomic_load(p, __ATOMIC_RELAXED, __HIP_MEMORY_SCOPE_AGENT); }
__device__ __forceinline__ unsigned xb_add(unsigned* p, unsigned v) { return __hip_atomic_fetch_add(p, v, __ATOMIC_RELAXED, __HIP_MEMORY_SCOPE_AGENT); }
__device__ __forceinline__ unsigned xb_xcc_id() { return (unsigned)__builtin_amdgcn_s_getreg((3 << 11) | 20) & 0xFu; }
#define XB_SPIN(cond, bar) do { unsigned _sp = 0; while (cond) { __builtin_amdgcn_s_sleep(1); \
    if ((++_sp & 255u) == 0u) { if (xb_ld(&(bar)[XB_TMO])) break; if (_sp > XB_SPIN_CAP) { atomicAdd(&(bar)[XB_TMO], 1u); break; } } } } while (0)

struct XcdBarrier {
    unsigned* bar; unsigned x;
    volatile LAS unsigned* st;
};

__device__ __forceinline__ XcdBarrier xcd_barrier_post(unsigned* bar, volatile LAS unsigned* st) {
    XcdBarrier b; b.bar = bar; b.x = xb_xcc_id(); b.st = st;
    if (threadIdx.x == 0) (void)xb_add(&bar[XB_XCNT(b.x)], 1u);
    return b;
}
__device__ __forceinline__ void xcd_barrier_complete(unsigned* bar, unsigned x, unsigned& nloc, unsigned& nx) {
    const unsigned G = gridDim.x * gridDim.y * gridDim.z;
    unsigned sum, cnt, mine, sp = 0u;
    for (;;) {
        sum = 0u; cnt = 0u; mine = 0u;
#pragma unroll
        for (unsigned j = 0; j < 16; ++j) { const unsigned c = xb_ld(&bar[XB_XCNT(j)]); sum += c; cnt += (c > 0u) ? 1u : 0u; mine = (j == x) ? c : mine; }
        if (sum == G) break;
        __builtin_amdgcn_s_sleep(1);
        if ((++sp & 255u) == 0u) { if (xb_ld(&bar[XB_TMO])) break; if (sp > XB_SPIN_CAP) { atomicAdd(&bar[XB_TMO], 1u); break; } }
    }
    nloc = mine > 0u ? mine : 1u; nx = cnt > 0u ? cnt : 1u;
}

__device__ __forceinline__ void xcd_barrier(const XcdBarrier& b) {
    asm volatile("s_waitcnt vmcnt(0)" ::: "memory");
    __syncthreads();
    if (threadIdx.x == 0) {
        unsigned* bar = b.bar;
        __builtin_amdgcn_s_waitcnt(0);
        unsigned nloc = b.st[0], nx = b.st[1];
        if (nloc == 0u) { xcd_barrier_complete(bar, b.x, nloc, nx); b.st[0] = nloc; b.st[1] = nx; }
        const unsigned old = xb_add(&bar[XB_XSUB(b.x)], 1u);
        const unsigned gen = old / nloc;
        if (old + 1u == (gen + 1u) * nloc) {
            __builtin_amdgcn_fence(__ATOMIC_RELEASE, "agent");
            asm volatile("s_waitcnt vmcnt(0)" ::: "memory");
            const unsigned og = xb_add(&bar[XB_TOP], 1u);
            const unsigned tg = og / nx;
            if (og + 1u == (tg + 1u) * nx) xb_add(&bar[XB_TOPGEN], 1u);
            else XB_SPIN(xb_ld(&bar[XB_TOPGEN]) == tg, bar);
            __builtin_amdgcn_fence(__ATOMIC_ACQUIRE, "agent");
            xb_add(&bar[XB_XGEN(b.x)], 1u);
            asm volatile("s_waitcnt vmcnt(0)" ::: "memory");
        } else {
            XB_SPIN(xb_ld(&bar[XB_XGEN(b.x)]) == gen, bar);
            __builtin_amdgcn_fence(__ATOMIC_ACQUIRE, "agent");
            asm volatile("s_waitcnt vmcnt(0)" ::: "memory");
        }
    }
    __syncthreads();
}


DI void gsync(const Params& p) { XcdBarrier xb; xb.bar = (unsigned*)(p.ws + WS_BAR); xb.x = xb_xcc_id(); xb.st = (volatile LAS unsigned*)(smem + LDS_BYTES - 32); xcd_barrier(xb); }
template <int LAYER>
DI void layer_phases(const Params& p) {
  constexpr int B0 = 1 + 7 * LAYER;
#define PH_ON(k) (p.ph_lo <= (k) && (k) <= p.ph_hi)
#define PH_SYNC(k) do { if (p.ph_lo <= (k) && (k) < p.ph_hi) gsync(p); } while (0)
  if (PH_ON(B0 + 0)) { phase_rows(p, LAYER); phase_convert(p, LAYER); }
  PH_SYNC(B0 + 0);
  if (PH_ON(B0 + 1)) { phase_gemm1(p, LAYER); phase_gates(p); }
  PH_SYNC(B0 + 1);
  if (PH_ON(B0 + 2)) phase_qknorm(p, LAYER);
  PH_SYNC(B0 + 2);
  if (PH_ON(B0 + 3)) phase_x(p, LAYER);
  PH_SYNC(B0 + 3);
  if (PH_ON(B0 + 4)) phase_y(p, LAYER);
  PH_SYNC(B0 + 4);
  if (PH_ON(B0 + 5)) phase_yc(p, LAYER);
  PH_SYNC(B0 + 5);
  if (PH_ON(B0 + 6)) phase_gemm2(p, LAYER);
  PH_SYNC(B0 + 6);
}
__global__ void __launch_bounds__(512) fwd_megakernel(Params p) {
  cg::grid_group grid = cg::this_grid();
  volatile LAS unsigned* st = (volatile LAS unsigned*)(smem + LDS_BYTES - 32);
  unsigned* bar = (unsigned*)(p.ws + WS_BAR);
  if (threadIdx.x == 0) { st[0] = 0u; st[1] = 0u; }
  if (blockIdx.x == 0) { for (int i = threadIdx.x; i < XCD_BAR_WORDS; i += 512) bar[i] = 0u; }
  if (PH_ON(0)) phase_mod(p);
  grid.sync();
  (void)xcd_barrier_post(bar, st);
  layer_phases<0>(p);
  layer_phases<1>(p);
  if (PH_ON(15)) phase_final_ln(p);
}

extern "C" void kernel_launch(void* const* d_in, const int* in_sizes, int n_in, void* d_out, int out_size, void* d_ws, size_t ws_size, hipStream_t stream) {
  static int grid_blocks = 0;
  if (!grid_blocks) {
    if (ws_size < WS_END) { fprintf(stderr, "kernel_launch: workspace too small: %zu < %zu\n", ws_size, (size_t)WS_END); return; }
    if (hipFuncSetAttribute((const void*)fwd_megakernel, hipFuncAttributeMaxDynamicSharedMemorySize, LDS_BYTES) != hipSuccess) { fprintf(stderr, "kernel_launch: LDS attribute failed\n"); return; }
    int dev = 0, cus = 0, per_cu = 0;
    hipGetDevice(&dev);
    hipDeviceGetAttribute(&cus, hipDeviceAttributeMultiprocessorCount, dev);
    hipOccupancyMaxActiveBlocksPerMultiprocessor(&per_cu, fwd_megakernel, 512, LDS_BYTES);
    if (per_cu < 1) { fprintf(stderr, "kernel_launch: occupancy query returned %d\n", per_cu); return; }
    grid_blocks = cus;
  }
  Params p{};
  p.x = (const float*)d_in[0]; p.c = (const float*)d_in[1]; p.ctx = (const float*)d_in[2]; p.c_ctx = (const float*)d_in[3];
  p.w_mod = (const float*)d_in[4]; p.b_mod = (const float*)d_in[5]; p.w_in = (const float*)d_in[6]; p.q_norm = (const float*)d_in[7];
  p.k_norm = (const float*)d_in[8]; p.rpb = (const float*)d_in[9]; p.conv_w = (const float*)d_in[10]; p.a_log = (const float*)d_in[11];
  p.dt_bias = (const float*)d_in[12]; p.o_norm = (const float*)d_in[13]; p.w_out = (const float*)d_in[14]; p.ln_g = (const float*)d_in[15]; p.ln_b = (const float*)d_in[16];
  p.out = (float*)d_out; p.ws = (char*)d_ws; p.ph_lo = 0; p.ph_hi = 15;
  void* args[] = {&p};
  hipError_t e = hipLaunchCooperativeKernel((void*)fwd_megakernel, dim3(grid_blocks), dim3(512), args, LDS_BYTES, stream);
  if (e != hipSuccess) fprintf(stderr, "cooperative launch failed: %s (grid %d)\n", hipGetErrorString(e), grid_blocks);
}
```
